# Optimizing an MI355X kernel written in HIP

```python
import math
import jax, jax.numpy as jnp
from jax import lax
import numpy as np

D_MODEL = 1024
BATCH = 4
SEQ = 8192
DEPTH = 2

D_MIX = D_MODEL
HEAD_DIM = 64
D_POOL = D_MIX // 4
D_CONV = D_MIX // 4
D_NSA = D_MIX // 2
N_POOL_GROUPS = 4
POOL_GROUP = D_POOL // N_POOL_GROUPS
POOL_WINDOWS = (2, 4, 8, 16)
CONV_WIDTH = 3
N_HEADS = D_NSA // HEAD_DIM
N_KV = 2
GROUP = N_HEADS // N_KV
D_KV = N_KV * HEAD_DIM
CMP_BLOCK = 32
CMP_STRIDE = 16
CMP_HIDDEN = 128
SLC_BLOCK = 64
N_SELECT = 16
N_LOCAL = 2
WINDOW = 512
Q_BLOCK = 128
N_BUCKETS = 32
MAX_DISTANCE = 128
ALPHA = (2 * DEPTH) ** 0.25
BETA = (8 * DEPTH) ** -0.25
LN_EPS = 1e-5
NEG = -1e30
FORCED = 1e9
PROJ_SIZES = (D_POOL, D_POOL,
              D_CONV, D_CONV, D_CONV, D_CONV,
              D_NSA, D_KV, D_KV, D_KV, D_KV, D_KV, D_KV, 3 * N_HEADS, D_NSA)
D_PROJ = sum(PROJ_SIZES)

kernel_name = 'hymba_pool_conv_nsa_deepnorm'


def layer_norm(x, g, b):
    xf = x.astype(jnp.float32)
    mu = jnp.mean(xf, axis=-1, keepdims=True)
    var = jnp.mean(jnp.square(xf - mu), axis=-1, keepdims=True)
    return ((xf - mu) * lax.rsqrt(var + LN_EPS) * g + b).astype(x.dtype)


def rel_bucket(dist):
    n = jnp.maximum(dist, 0)
    max_exact = N_BUCKETS // 2
    nf = jnp.maximum(n, 1).astype(jnp.float32)
    large = max_exact + (jnp.log(nf / max_exact) / math.log(MAX_DISTANCE / max_exact)
                         * (N_BUCKETS - max_exact)).astype(jnp.int32)
    large = jnp.minimum(large, N_BUCKETS - 1)
    return jnp.where(n < max_exact, n, large)


def pool_mixer(v, w_grp, scale):
    B_, T, _ = v.shape
    vf = v.astype(jnp.float32)
    cs = jnp.pad(jnp.cumsum(vf, axis=1), ((0, 0), (1, 0), (0, 0)))
    pos = jnp.arange(T)
    outs = []
    for gi, w in enumerate(POOL_WINDOWS):
        sl = slice(gi * POOL_GROUP, (gi + 1) * POOL_GROUP)
        start = jnp.maximum(pos + 1 - w, 0)
        cnt = (pos + 1 - start).astype(jnp.float32)[None, :, None]
        outs.append((cs[:, 1:, sl] - cs[:, start, sl]) / cnt - vf[..., sl])
    p = jnp.stack(outs, axis=2)
    y = jnp.einsum('btgc,gcd->btgd', p, w_grp).reshape(B_, T, D_POOL)
    return (y * scale).astype(v.dtype)


def short_conv_mixer(b, c, xin, conv_w):
    u = c * xin
    T = u.shape[1]
    up = jnp.pad(u, ((0, 0), (CONV_WIDTH - 1, 0), (0, 0)))
    y = sum(conv_w[k] * up[:, k:k + T] for k in range(CONV_WIDTH))
    return b * y


def compress(kv, pe, w1, w2):
    B_, T = kv.shape[:2]
    n_cmp = (T - CMP_BLOCK) // CMP_STRIDE + 1
    idx = jnp.arange(n_cmp)[:, None] * CMP_STRIDE + jnp.arange(CMP_BLOCK)[None, :]
    blk = kv[:, idx] + pe[None, None, :, None, :]
    blk = jnp.moveaxis(blk, 3, 2).reshape(B_, n_cmp, N_KV, CMP_BLOCK * HEAD_DIM)
    out = jax.nn.silu(blk @ w1) @ w2
    return out.transpose(0, 2, 1, 3)


def nsa_mixer(q, k_cmp, v_cmp, k_slc, v_slc, k_win, v_win, gates,
              pe_k, w1_k, w2_k, pe_v, w1_v, w2_v, rel_bias):
    B_, T = q.shape[:2]
    f32 = jnp.float32
    n_cmp = (T - CMP_BLOCK) // CMP_STRIDE + 1
    n_slc = T // SLC_BLOCK
    n_qb = T // Q_BLOCK
    k_sel = min(N_SELECT, n_slc)
    heads = lambda a: a.reshape(B_, T, N_KV, HEAD_DIM)
    kc = compress(heads(k_cmp), pe_k, w1_k, w2_k).astype(f32)
    vc = compress(heads(v_cmp), pe_v, w1_v, w2_v).astype(f32)
    ksb = heads(k_slc).transpose(0, 2, 1, 3).reshape(B_, N_KV, n_slc, SLC_BLOCK, HEAD_DIM)
    vsb = heads(v_slc).transpose(0, 2, 1, 3).reshape(B_, N_KV, n_slc, SLC_BLOCK, HEAD_DIM)
    pad = ((0, 0), (0, 0), (WINDOW, 0), (0, 0))
    kwp = jnp.pad(heads(k_win).transpose(0, 2, 1, 3), pad)
    vwp = jnp.pad(heads(v_win).transpose(0, 2, 1, 3), pad)
    qbl = q.reshape(B_, n_qb, Q_BLOCK, N_KV, GROUP, HEAD_DIM).transpose(1, 0, 3, 4, 2, 5)
    gbl = gates.reshape(B_, n_qb, Q_BLOCK, N_KV, GROUP, 3).transpose(1, 0, 3, 4, 2, 5)
    rel_gr = rel_bias.T.reshape(N_KV, GROUP, N_BUCKETS).astype(f32)
    cstart = np.arange(n_cmp)[:, None] * CMP_STRIDE
    sstart = np.arange(n_slc)[None, :] * SLC_BLOCK
    overlap = np.clip(np.minimum(cstart + CMP_BLOCK, sstart + SLC_BLOCK) - np.maximum(cstart, sstart), 0, None)
    ov = jnp.asarray(overlap / CMP_STRIDE, dtype=f32)
    cmp_end = jnp.arange(n_cmp) * CMP_STRIDE + CMP_BLOCK - 1
    slc_idx = jnp.arange(n_slc)
    bi = jnp.arange(B_)[:, None, None, None]
    gi = jnp.arange(N_KV)[None, :, None, None]
    g5 = jnp.arange(N_KV)[None, :, None, None, None]
    r5 = jnp.arange(GROUP)[None, None, :, None, None]
    scale = HEAD_DIM ** -0.5

    def masked_softmax(s, m):
        return jnp.where(m, jax.nn.softmax(jnp.where(m, s, NEG), axis=-1), 0.0)

    def block(args):
        qb, gb, qi = args
        t = qi * Q_BLOCK + jnp.arange(Q_BLOCK)
        qf = qb.astype(f32) * scale
        d1 = t[:, None] - cmp_end[None, :]
        m1 = d1 >= 0
        s1 = jnp.einsum('bgrqd,bgnd->bgrqn', qf, kc) + rel_gr[:, :, rel_bucket(d1)]
        p1 = masked_softmax(s1, m1)
        o1 = jnp.einsum('bgrqn,bgnd->bgrqd', p1, vc)
        imp = jnp.einsum('bgrqn,nj->bgqj', p1, ov)
        back = (t // SLC_BLOCK)[:, None] - slc_idx[None, :]
        forced = (slc_idx[None, :] == 0) | ((back >= 0) & (back < N_LOCAL))
        score = jnp.where(forced, FORCED, jnp.where(back >= 0, imp, NEG))
        _, sel = lax.top_k(score, k_sel)
        kg = ksb[bi, gi, sel].reshape(B_, N_KV, Q_BLOCK, k_sel * SLC_BLOCK, HEAD_DIM).astype(f32)
        vg = vsb[bi, gi, sel].reshape(B_, N_KV, Q_BLOCK, k_sel * SLC_BLOCK, HEAD_DIM).astype(f32)
        kpos = (sel[..., None] * SLC_BLOCK + jnp.arange(SLC_BLOCK)).reshape(B_, N_KV, Q_BLOCK, -1)
        d2 = t[None, None, :, None] - kpos
        m2 = (d2 >= 0)[:, :, None]
        s2 = jnp.einsum('bgrqd,bgqkd->bgrqk', qf, kg) + rel_gr[g5, r5, rel_bucket(d2)[:, :, None]]
        o2 = jnp.einsum('bgrqk,bgqkd->bgrqd', masked_softmax(s2, m2), vg)
        start = qi * Q_BLOCK
        kw = lax.dynamic_slice_in_dim(kwp, start, Q_BLOCK + WINDOW, axis=2).astype(f32)
        vw = lax.dynamic_slice_in_dim(vwp, start, Q_BLOCK + WINDOW, axis=2).astype(f32)
        kpos3 = start - WINDOW + jnp.arange(Q_BLOCK + WINDOW)
        d3 = t[:, None] - kpos3[None, :]
        m3 = (d3 >= 0) & (d3 < WINDOW) & (kpos3[None, :] >= 0)
        s3 = jnp.einsum('bgrqd,bgkd->bgrqk', qf, kw) + rel_gr[:, :, rel_bucket(d3)]
        o3 = jnp.einsum('bgrqk,bgkd->bgrqd', masked_softmax(s3, m3), vw)
        g = jax.nn.sigmoid(gb.astype(f32))
        return g[..., 0:1] * o1 + g[..., 1:2] * o2 + g[..., 2:3] * o3

    out = lax.map(block, (qbl, gbl, jnp.arange(n_qb)))
    return out.transpose(1, 0, 4, 2, 3, 5).reshape(B_, T, D_NSA).astype(q.dtype)


def hybrid_layer(x, w_in, w_out, pool_w, pool_scale, conv_w,
                 pe_k, w1_k, w2_k, pe_v, w1_v, w2_v, rel_bias, ln_g, ln_b):
    proj = x @ w_in
    split_points = np.cumsum(PROJ_SIZES)[:-1].tolist()
    (pool_v, pool_z, conv_b, conv_c, conv_x, conv_z,
     q, k_cmp, v_cmp, k_slc, v_slc, k_win, v_win, gates, nsa_z) = jnp.split(proj, split_points, axis=-1)
    y_pool = jax.nn.silu(pool_z) * pool_mixer(pool_v, pool_w, pool_scale)
    y_conv = jax.nn.silu(conv_z) * short_conv_mixer(conv_b, conv_c, conv_x, conv_w)
    y_nsa = jax.nn.silu(nsa_z) * nsa_mixer(q, k_cmp, v_cmp, k_slc, v_slc, k_win, v_win, gates,
                                           pe_k, w1_k, w2_k, pe_v, w1_v, w2_v, rel_bias)
    y = jnp.concatenate([y_pool, y_conv, y_nsa], axis=-1) @ w_out
    return layer_norm(ALPHA * x + y, ln_g, ln_b)


def setup_inputs(seed: int = 0) -> dict:
    key = jax.random.key(seed)
    ks = jax.random.split(key, 16)
    f = jnp.float32
    nrm = lambda k, s: jax.random.normal(k, s, f)
    return {
        'x': nrm(ks[0], (BATCH, SEQ, D_MODEL)),
        'w_in': nrm(ks[1], (DEPTH, D_MODEL, D_PROJ)) * D_MODEL ** -0.5,
        'w_out': nrm(ks[2], (DEPTH, D_MIX, D_MODEL)) * (D_MIX ** -0.5 * BETA),
        'pool_w': nrm(ks[3], (DEPTH, N_POOL_GROUPS, POOL_GROUP, POOL_GROUP)) * POOL_GROUP ** -0.5,
        'pool_scale': 1.0 + 0.1 * nrm(ks[4], (DEPTH, D_POOL)),
        'conv_w': nrm(ks[5], (DEPTH, CONV_WIDTH, D_CONV)) * CONV_WIDTH ** -0.5,
        'cmp_pe_k': 0.1 * nrm(ks[6], (DEPTH, CMP_BLOCK, HEAD_DIM)),
        'cmp_w1_k': nrm(ks[7], (DEPTH, CMP_BLOCK * HEAD_DIM, CMP_HIDDEN)) * (CMP_BLOCK * HEAD_DIM) ** -0.5,
        'cmp_w2_k': nrm(ks[8], (DEPTH, CMP_HIDDEN, HEAD_DIM)) * (2.0 * CMP_HIDDEN ** -0.5),
        'cmp_pe_v': 0.1 * nrm(ks[9], (DEPTH, CMP_BLOCK, HEAD_DIM)),
        'cmp_w1_v': nrm(ks[10], (DEPTH, CMP_BLOCK * HEAD_DIM, CMP_HIDDEN)) * (CMP_BLOCK * HEAD_DIM) ** -0.5,
        'cmp_w2_v': nrm(ks[11], (DEPTH, CMP_HIDDEN, HEAD_DIM)) * (2.0 * CMP_HIDDEN ** -0.5),
        'rel_bias': 0.5 * nrm(ks[12], (N_BUCKETS, N_HEADS)),
        'ln_g': 1.0 + 0.02 * nrm(ks[13], (DEPTH, D_MODEL)),
        'ln_b': 0.02 * nrm(ks[14], (DEPTH, D_MODEL)),
    }


def reference(x, w_in, w_out, pool_w, pool_scale, conv_w, cmp_pe_k, cmp_w1_k, cmp_w2_k,
              cmp_pe_v, cmp_w1_v, cmp_w2_v, rel_bias, ln_g, ln_b):
    h = x
    for l in range(DEPTH):
        h = hybrid_layer(h, w_in[l], w_out[l], pool_w[l], pool_scale[l], conv_w[l],
                         cmp_pe_k[l], cmp_w1_k[l], cmp_w2_k[l],
                         cmp_pe_v[l], cmp_w1_v[l], cmp_w2_v[l],
                         rel_bias, ln_g[l], ln_b[l])
    return h
```

```cpp
#include <hip/hip_runtime.h>
#include <hip/hip_bf16.h>
#include <cstdio>
#include <cstdint>
namespace pg8 {
#define PG8_LAS __attribute__((address_space(3)))
typedef unsigned short bf16_t;
typedef short bf16x8 __attribute__((ext_vector_type(8)));
typedef float f32x4 __attribute__((ext_vector_type(4)));
typedef unsigned u32x4 __attribute__((ext_vector_type(4)));
constexpr int BM = 256, BK = 64, HALF = 128, HTB = HALF * BK * 2  , STAGE_BYTES = 8 * HTB, NXCD = 8, WGM = 8;

__host__ __device__ __forceinline__ int lds_byte(int r, int c) { const int st = (r >> 4) * 2 + (c >> 5), rr = r & 15, cc = c & 31, ob = rr * 64 + cc * 2; return st * 1024 + (ob ^ (((ob >> 9) & 1) << 5)); }
__host__ __device__ __forceinline__ void stage_rc(int b, int& R, int& C) { const int st = b / 1024, sb = b % 1024, swz = sb ^ (((sb >> 9) & 1) << 5); R = (st >> 1) * 16 + swz / 64; C = (st & 1) * 32 + (swz % 64) / 2; }
__host__ __device__ __forceinline__ int perm32(int rho) { const int n = rho >> 4, i = rho & 15; return 8 * (i >> 2) + 4 * n + (i & 3); }

struct Unit { int pm, pn; };
struct Gemm { const bf16_t* A; const bf16_t* Bt; int M, N, K; };

struct StaticOrder {
    int nM, nN, nwg, G, c;
    __host__ __device__ void init(int M, int N, int G_, int c_) { nM = M / BM; nN = N / BM; nwg = nM * nN; G = G_; c = c_; }
    __host__ __device__ bool next(int i, Unit& u) const {
        const long L = (long)i * G + c; if (L >= nwg) return false;
        int wgid = (int)L; { const int q = nwg / NXCD, r = nwg % NXCD, xcd = wgid % NXCD, off = wgid / NXCD; wgid = (xcd < r ? xcd * (q + 1) : r * (q + 1) + (xcd - r) * q) + off; }
        const int nig = WGM * nN, gid = wgid / nig, fm = gid * WGM, gsz = (nM - fm) < WGM ? (nM - fm) : WGM;
        u.pm = fm + ((wgid % nig) % gsz); u.pn = (wgid % nig) / gsz; return true;
    }
    __device__ __forceinline__ void a_ready(const Unit&) const {}
    __device__ __forceinline__ void done(const Unit&) const {}
};
__device__ __forceinline__ unsigned cvt_pk_bf16(float lo, float hi) { unsigned r; asm volatile("v_cvt_pk_bf16_f32 %0, %1, %2" : "=v"(r) : "v"(lo), "v"(hi)); return r; }

struct EpiBf16 {
    static constexpr bool PERM = true, AFTER_DRAIN = false;
    bf16_t* O; int ldc;
    __device__ __forceinline__ void operator()(const f32x4 (&acc)[2][2][4][2], const Unit& u, int wr, int wc, int fr, int fq) const {
        const int row0 = u.pm * BM + wr * 64 + fr; const int col0 = u.pn * BM + wc * 32 + 8 * fq;
#pragma unroll
        for (int ai = 0; ai < 2; ++ai)
#pragma unroll
            for (int m = 0; m < 4; ++m) { bf16_t* rowp = O + (size_t)(row0 + ai * HALF + m * 16) * ldc + col0;
#pragma unroll
                for (int bj = 0; bj < 2; ++bj) { const f32x4 v0 = acc[ai][bj][m][0], v1 = acc[ai][bj][m][1];
                    u32x4 w; w.x = cvt_pk_bf16(v0[0], v0[1]); w.y = cvt_pk_bf16(v0[2], v0[3]); w.z = cvt_pk_bf16(v1[0], v1[1]); w.w = cvt_pk_bf16(v1[2], v1[3]);
                    *(u32x4*)(rowp + bj * HALF) = w; } }
    }
};
struct EpiResid {
    static constexpr bool PERM = false, AFTER_DRAIN = false;
    const float* base; float* out; int ldc; float alpha;
    __device__ __forceinline__ void operator()(const f32x4 (&acc)[2][2][4][2], const Unit& u, int wr, int wc, int fr, int fq) const {
        const int col0 = u.pn * BM + wc * 32 + 4 * fq;
#pragma unroll
        for (int ai = 0; ai < 2; ++ai)
#pragma unroll
            for (int m = 0; m < 4; ++m) { const size_t off = (size_t)(u.pm * BM + ai * HALF + wr * 64 + m * 16 + fr) * ldc + col0;
#pragma unroll
                for (int bj = 0; bj < 2; ++bj)
#pragma unroll
                    for (int n = 0; n < 2; ++n) { const f32x4 bs = *(const f32x4*)(base + off + bj * HALF + n * 16);
                        *(f32x4*)(out + off + bj * HALF + n * 16) = bs * alpha + acc[ai][bj][m][n]; } }
    }
};
template <class Epi, class Sched, bool ALIGN_EPI = false, bool SP2 = false>
__device__ __forceinline__ void gemm_phase(PG8_LAS unsigned char* lds, const Gemm g, const Sched& S, const Epi& E) {
    int tid_ = threadIdx.x; asm volatile("" : "+v"(tid_));
    const int tid = tid_, wid = __builtin_amdgcn_readfirstlane(tid >> 6), lane = tid & 63, wr = wid >> 2, wc = wid & 3, fr = lane & 15, fq = lane >> 4;
    const int K = g.K, nt = K / BK;
    unsigned voffA[2], voffB[2];
#pragma unroll
    for (int i = 0; i < 2; ++i) { int R, C; stage_rc(tid * 16 + i * 8192, R, C); const int Rb = Epi::PERM ? ((R & ~31) + perm32(R & 31)) : R;
        voffA[i] = (unsigned)(R * K + C) * 2u; voffB[i] = (unsigned)(Rb * K + C) * 2u; }
    const size_t kstep = (size_t)(BK * 2);
    const size_t hstep = (size_t)HALF * K * 2;
    const size_t tstep = 2 * hstep;
    const unsigned ldsw = (unsigned)wid * 1024u;
    const int aoff = lds_byte(wr * 64 + fr, fq * 8), boff = lds_byte(wc * 32 + fr, fq * 8);
#define PG8_SA(b, h) (((b) * 2 + (h)) * HTB)
#define PG8_SB(b, h) ((4 + (b) * 2 + (h)) * HTB)
#define PG8_STAGE(bufoff, gbase, voff) do { _Pragma("unroll") for (int _i = 0; _i < 2; ++_i) \
        __builtin_amdgcn_global_load_lds((const unsigned*)((const char*)(gbase) + (voff)[_i]), (PG8_LAS unsigned*)(lds + (bufoff) + ldsw + _i * 8192), 16, 0, 0); } while (0)
#define PG8_LDA(dst, b, h) do { _Pragma("unroll") for (int m = 0; m < 4; ++m) _Pragma("unroll") for (int k = 0; k < 2; ++k) dst[m][k] = *(const PG8_LAS bf16x8*)(lds + PG8_SA(b, h) + aoff + m * 2048 + k * 1024); } while (0)
#define PG8_LDB(dst, b, h) do { _Pragma("unroll") for (int n = 0; n < 2; ++n) _Pragma("unroll") for (int k = 0; k < 2; ++k) dst[n][k] = *(const PG8_LAS bf16x8*)(lds + PG8_SB(b, h) + boff + n * 2048 + k * 1024); } while (0)
#define PG8_MMA(ai, bj, At, Bt) do { __builtin_amdgcn_s_setprio(1); _Pragma("unroll") for (int m = 0; m < 4; ++m) _Pragma("unroll") for (int n = 0; n < 2; ++n) _Pragma("unroll") for (int k = 0; k < 2; ++k) \
        acc[ai][bj][m][n] = __builtin_amdgcn_mfma_f32_16x16x32_bf16(Bt[n][k], At[m][k], acc[ai][bj][m][n], 0, 0, 0); __builtin_amdgcn_s_setprio(0); } while (0)
#define PG8_WAIT_V(n) asm volatile("s_waitcnt vmcnt(" #n ")" ::: "memory")
#define PG8_WAIT_L(n) asm volatile("s_waitcnt lgkmcnt(" #n ")" ::: "memory")
#define PG8_BAR __builtin_amdgcn_s_barrier()
#define PG8_SCHED __builtin_amdgcn_sched_barrier(0)
    Unit cur, nxt; int ui = 0;
    if (!S.next(0, cur)) return;
    f32x4 acc[2][2][4][2];
#pragma unroll
    for (int a = 0; a < 2; ++a)
#pragma unroll
        for (int b = 0; b < 2; ++b)
#pragma unroll
            for (int m = 0; m < 4; ++m)
#pragma unroll
                for (int n = 0; n < 2; ++n) acc[a][b][m][n] = (f32x4){0.f, 0.f, 0.f, 0.f};
    bf16x8 At[4][2], B0[2][2], B1[2][2];
    const char* cA = (const char*)g.A + (size_t)cur.pm * tstep; const char* cB = (const char*)g.Bt + (size_t)cur.pn * tstep;
    S.a_ready(cur);
    if constexpr (SP2) {
        PG8_STAGE(PG8_SB(0, 0), cB, voffB); PG8_STAGE(PG8_SB(0, 1), cB + hstep, voffB); PG8_STAGE(PG8_SA(0, 0), cA, voffA); PG8_STAGE(PG8_SA(0, 1), cA + hstep, voffA);
        if (wr == 1) PG8_BAR;
        PG8_WAIT_V(2); PG8_BAR;
        PG8_STAGE(PG8_SB(1, 0), cB + kstep, voffB); PG8_STAGE(PG8_SA(1, 0), cA + kstep, voffA); PG8_STAGE(PG8_SB(1, 1), cB + hstep + kstep, voffB);
        PG8_WAIT_V(6); PG8_BAR;
    } else {
        PG8_STAGE(PG8_SB(0, 0), cB, voffB); PG8_STAGE(PG8_SA(0, 0), cA, voffA); PG8_STAGE(PG8_SB(0, 1), cB + hstep, voffB); PG8_STAGE(PG8_SA(0, 1), cA + hstep, voffA);
        if (wr == 1) PG8_BAR;
        PG8_WAIT_V(4); PG8_BAR;
        PG8_STAGE(PG8_SB(1, 0), cB + kstep, voffB); PG8_STAGE(PG8_SA(1, 0), cA + kstep, voffA); PG8_STAGE(PG8_SB(1, 1), cB + hstep + kstep, voffB);
        PG8_WAIT_V(6); PG8_BAR;
    }
    for (;;) {
        const bool has_next = S.next(ui + 1, nxt);
        const char* nA = has_next ? (const char*)g.A + (size_t)nxt.pm * tstep : cA; const char* nB = has_next ? (const char*)g.Bt + (size_t)nxt.pn * tstep : cB;
        for (int t = 0; t < nt; t += 2) {
            const bool last = (t == nt - 2);
            const char* a1 = cA + (size_t)(t + 1) * kstep;
            const char* a2 = last ? nA : cA + (size_t)(t + 2) * kstep; const char* b2 = last ? nB : cB + (size_t)(t + 2) * kstep;
            const char* a3 = a2 + kstep; const char* b3 = b2 + kstep;
            if (last && has_next) S.a_ready(nxt);
            if constexpr (SP2) {
            PG8_LDB(B0, 0, 0); PG8_LDB(B1, 0, 1); PG8_SCHED; PG8_LDA(At, 0, 0); PG8_STAGE(PG8_SA(1, 1), a1 + hstep, voffA);
            PG8_WAIT_V(8); PG8_WAIT_L(0); PG8_BAR; PG8_MMA(0, 0, At, B0); PG8_MMA(0, 1, At, B1); PG8_BAR; PG8_SCHED;
            PG8_LDA(At, 0, 1); PG8_STAGE(PG8_SB(0, 0), b2, voffB); PG8_STAGE(PG8_SB(0, 1), b2 + hstep, voffB); PG8_STAGE(PG8_SA(0, 0), a2, voffA);
            PG8_WAIT_V(8); PG8_WAIT_L(0); PG8_BAR; PG8_MMA(1, 0, At, B0); PG8_MMA(1, 1, At, B1); PG8_BAR; PG8_SCHED;
            PG8_LDB(B0, 1, 0); PG8_LDB(B1, 1, 1); PG8_SCHED; PG8_LDA(At, 1, 0); PG8_STAGE(PG8_SA(0, 1), a2 + hstep, voffA);
            PG8_WAIT_V(8); PG8_WAIT_L(0); PG8_BAR; PG8_MMA(0, 0, At, B0); PG8_MMA(0, 1, At, B1); PG8_BAR; PG8_SCHED;
            PG8_LDA(At, 1, 1); PG8_STAGE(PG8_SB(1, 0), b3, voffB); PG8_STAGE(PG8_SB(1, 1), b3 + hstep, voffB); PG8_STAGE(PG8_SA(1, 0), a3, voffA);
            PG8_WAIT_V(8); PG8_WAIT_L(0); PG8_BAR; PG8_MMA(1, 0, At, B0); PG8_MMA(1, 1, At, B1); PG8_BAR; PG8_SCHED;
            } else {
            PG8_LDB(B0, 0, 0); PG8_SCHED; PG8_LDA(At, 0, 0); PG8_STAGE(PG8_SA(1, 1), a1 + hstep, voffA);
            PG8_WAIT_L(8); PG8_BAR; PG8_WAIT_L(0); PG8_MMA(0, 0, At, B0); PG8_BAR; PG8_SCHED;
            PG8_LDB(B1, 0, 1); PG8_STAGE(PG8_SB(0, 0), b2, voffB);
            PG8_BAR; PG8_WAIT_L(0); PG8_MMA(0, 1, At, B1); PG8_BAR;
            PG8_LDA(At, 0, 1); PG8_STAGE(PG8_SA(0, 0), a2, voffA);
            PG8_BAR; PG8_WAIT_L(0); PG8_MMA(1, 0, At, B0); PG8_BAR; PG8_SCHED;
            PG8_STAGE(PG8_SB(0, 1), b2 + hstep, voffB);
            PG8_WAIT_V(6); PG8_BAR; PG8_MMA(1, 1, At, B1); PG8_BAR;
            PG8_LDB(B0, 1, 0); PG8_SCHED; PG8_LDA(At, 1, 0); PG8_STAGE(PG8_SA(0, 1), a2 + hstep, voffA);
            PG8_WAIT_L(8); PG8_BAR; PG8_WAIT_L(0); PG8_MMA(0, 0, At, B0); PG8_BAR; PG8_SCHED;
            PG8_LDB(B1, 1, 1); PG8_STAGE(PG8_SB(1, 0), b3, voffB);
            PG8_BAR; PG8_WAIT_L(0); PG8_MMA(0, 1, At, B1); PG8_BAR;
            PG8_LDA(At, 1, 1); PG8_STAGE(PG8_SA(1, 0), a3, voffA);
            PG8_BAR; PG8_WAIT_L(0); PG8_MMA(1, 0, At, B0); PG8_BAR; PG8_SCHED;
            PG8_STAGE(PG8_SB(1, 1), b3 + hstep, voffB);
            PG8_WAIT_V(6); PG8_BAR; PG8_MMA(1, 1, At, B1); PG8_BAR;
            }
        }
        if constexpr (ALIGN_EPI) { if (wr == 0) PG8_BAR; }
        if constexpr (!Epi::AFTER_DRAIN) { E(acc, cur, wr, wc, fr, fq); S.done(cur); }
        if (!has_next) break;
#pragma unroll
        for (int a = 0; a < 2; ++a)
#pragma unroll
            for (int b = 0; b < 2; ++b)
#pragma unroll
                for (int m = 0; m < 4; ++m)
#pragma unroll
                    for (int n = 0; n < 2; ++n) acc[a][b][m][n] = (f32x4){0.f, 0.f, 0.f, 0.f};
        cur = nxt; cA = nA; cB = nB; ++ui;
        if constexpr (ALIGN_EPI) { if (wr == 1) PG8_BAR; }
    }
    PG8_WAIT_V(0);
    if constexpr (!ALIGN_EPI) { if (wr == 0) PG8_BAR; }
    PG8_BAR;
    if constexpr (Epi::AFTER_DRAIN) { E.fused(acc, cur, wr, wc, fr, fq, lds, wid, lane); S.done(cur); }
#undef PG8_SA
#undef PG8_SB
#undef PG8_STAGE
#undef PG8_LDA
#undef PG8_LDB
#undef PG8_MMA
#undef PG8_WAIT_V
#undef PG8_WAIT_L
#undef PG8_BAR
#undef PG8_SCHED
}
}
#define GAS __attribute__((address_space(1)))
#define LAS __attribute__((address_space(3)))
typedef unsigned short bf16;
typedef unsigned v4u __attribute__((ext_vector_type(4)));
typedef float f32x4 __attribute__((ext_vector_type(4)));
typedef short bf16x8 __attribute__((ext_vector_type(8)));
typedef GAS unsigned gu32;
typedef GAS unsigned long long gu64;
#define RLX_AGENT __ATOMIC_RELAXED, __HIP_MEMORY_SCOPE_AGENT
#define LDS_WAIT() asm volatile("s_waitcnt lgkmcnt(0)" ::: "memory")
#define VM_WAIT() asm volatile("s_waitcnt vmcnt(0)" ::: "memory")
__device__ __forceinline__ unsigned long long rt() { return __builtin_amdgcn_s_memrealtime(); }
__device__ __forceinline__ unsigned f2bf(float f) { unsigned u = __builtin_bit_cast(unsigned, f); return (u + 0x7fffu + ((u >> 16) & 1u)) >> 16; }
__device__ __forceinline__ unsigned pk2(float lo, float hi) { return f2bf(lo) | (f2bf(hi) << 16); }
#define XB_TMO      128
#define XB_XCNT(j)  (256  + 64 * (j))
#define XB_XSUB(j)  (1280 + 64 * (j))
#define XB_XGEN(j)  (2304 + 64 * (j))
#define XB_TOP      3328
#define XB_TOPGEN   3392
#define XCD_BAR_WORDS 3456
#define XB_SPIN_CAP (1u << 18)

__device__ __forceinline__ unsigned xb_ld(unsigned* p)              { return __hip_atomic_load(p, __ATOMIC_RELAXED, __HIP_MEMORY_SCOPE_AGENT); }
__device__ __forceinline__ unsigned xb_add(unsigned* p, unsigned v) { return __hip_atomic_fetch_add(p, v, __ATOMIC_RELAXED, __HIP_MEMORY_SCOPE_AGENT); }
__device__ __forceinline__ unsigned xb_xcc_id() { return (unsigned)__builtin_amdgcn_s_getreg((3 << 11) | 20) & 0xFu; }
#define XB_SPIN(cond, bar) do { unsigned _sp = 0; while (cond) { __builtin_amdgcn_s_sleep(1); \
    if ((++_sp & 255u) == 0u) { if (xb_ld(&(bar)[XB_TMO])) break; if (_sp > XB_SPIN_CAP) { atomicAdd(&(bar)[XB_TMO], 1u); break; } } } } while (0)

struct XcdBarrier {
    unsigned* bar; unsigned x;
    volatile LAS unsigned* st;
};

__device__ __forceinline__ XcdBarrier xcd_barrier_post(unsigned* bar, volatile LAS unsigned* st) {
    XcdBarrier b; b.bar = bar; b.x = xb_xcc_id(); b.st = st;
    if (threadIdx.x == 0) (void)xb_add(&bar[XB_XCNT(b.x)], 1u);
    return b;
}
__device__ __forceinline__ void xcd_barrier_complete(unsigned* bar, unsigned x, unsigned& nloc, unsigned& nx) {
    const unsigned G = gridDim.x * gridDim.y * gridDim.z;
    unsigned sum, cnt, mine, sp = 0u;
    for (;;) {
        sum = 0u; cnt = 0u; mine = 0u;
#pragma unroll
        for (unsigned j = 0; j < 16; ++j) { const unsigned c = xb_ld(&bar[XB_XCNT(j)]); sum += c; cnt += (c > 0u) ? 1u : 0u; mine = (j == x) ? c : mine; }
        if (sum == G) break;
        __builtin_amdgcn_s_sleep(1);
        if ((++sp & 255u) == 0u) { if (xb_ld(&bar[XB_TMO])) break; if (sp > XB_SPIN_CAP) { atomicAdd(&bar[XB_TMO], 1u); break; } }
    }
    nloc = mine > 0u ? mine : 1u; nx = cnt > 0u ? cnt : 1u;
}

__device__ __forceinline__ void xcd_barrier(const XcdBarrier& b) {
    asm volatile("s_waitcnt vmcnt(0)" ::: "memory");
    __syncthreads();
    if (threadIdx.x == 0) {
        unsigned* bar = b.bar;
        __builtin_amdgcn_s_waitcnt(0);
        unsigned nloc = b.st[0], nx = b.st[1];
        if (nloc == 0u) { xcd_barrier_complete(bar, b.x, nloc, nx); b.st[0] = nloc; b.st[1] = nx; }
        const unsigned old = xb_add(&bar[XB_XSUB(b.x)], 1u);
        const unsigned gen = old / nloc;
        if (old + 1u == (gen + 1u) * nloc) {
            __builtin_amdgcn_fence(__ATOMIC_RELEASE, "agent");
            asm volatile("s_waitcnt vmcnt(0)" ::: "memory");
            const unsigned og = xb_add(&bar[XB_TOP], 1u);
            const unsigned tg = og / nx;
            if (og + 1u == (tg + 1u) * nx) xb_add(&bar[XB_TOPGEN], 1u);
            else XB_SPIN(xb_ld(&bar[XB_TOPGEN]) == tg, bar);
            __builtin_amdgcn_fence(__ATOMIC_ACQUIRE, "agent");
            xb_add(&bar[XB_XGEN(b.x)], 1u);
            asm volatile("s_waitcnt vmcnt(0)" ::: "memory");
        } else {
            XB_SPIN(xb_ld(&bar[XB_XGEN(b.x)]) == gen, bar);
            __builtin_amdgcn_fence(__ATOMIC_ACQUIRE, "agent");
            asm volatile("s_waitcnt vmcnt(0)" ::: "memory");
        }
    }
    __syncthreads();
}

constexpr int NWAVES = 8;
constexpr int BATCH = 4, SEQ = 8192, DM = 1024, DEPTH = 2, M = BATCH * SEQ;
constexpr int DPROJ = 3352, NP = 3584;
constexpr int C_POOLV = 0, C_POOLZ = 256, C_CONVB = 512, C_CONVC = 768, C_CONVX = 1024, C_CONVZ = 1280, C_Q = 1536,
              C_KCMP = 2048, C_VCMP = 2176, C_KSLC = 2304, C_VSLC = 2432, C_KWIN = 2560, C_VWIN = 2688, C_NSAZ = 2816, C_GATE = 3328;
constexpr float LN_EPS = 1e-5f, LOG2E = 1.4426950408889634f, QSCALE = 0.125f * LOG2E;
constexpr float ALPHA = 1.4142135623730951f;
constexpr int NCMP_PAD = 512;

constexpr size_t MiB = 1u << 20;
constexpr size_t WS_CTL = 0, CTL_ZERO_BYTES = 1 * MiB;
constexpr size_t WS_WIN = 2 * MiB;
constexpr size_t WS_WOUT = 16 * MiB;
constexpr size_t WS_W1T = 20 * MiB;
constexpr size_t WS_W2T = 22 * MiB;
constexpr size_t WS_PWT = 22 * MiB + 65536;
constexpr size_t WS_TBL = 22 * MiB + 131072;
constexpr size_t WS_XB = 32 * MiB;
constexpr size_t WS_PROJ = 96 * MiB;
constexpr size_t WS_VBUF = 96 * MiB;
constexpr size_t WS_KC = 320 * MiB, WS_VC = 320 * MiB + 524288;
constexpr size_t WS_YMIX = 322 * MiB;
constexpr size_t WS_END = 386 * MiB;
constexpr int CW_BAR = 4096;

constexpr int RING_BYTES = 131072;
constexpr int LDSCTL_OFF = 143360, MISC_OFF = LDSCTL_OFF + 320;
constexpr int LDS_BYTES = 147456;

__device__ __forceinline__ float bf2f(unsigned short h) { return __uint_as_float((unsigned)h << 16); }
__device__ __forceinline__ float ex2(float x) { return __builtin_amdgcn_exp2f(x); }
__device__ __forceinline__ float sigm(float x) { return __builtin_amdgcn_rcpf(1.f + ex2(-x * LOG2E)); }
__device__ __forceinline__ float silu(float x) { return x * sigm(x); }
__device__ __forceinline__ void unpack8(const v4u& w, float (&f)[8]) {
    f[0] = __uint_as_float(w.x << 16); f[1] = __uint_as_float(w.x & 0xffff0000u); f[2] = __uint_as_float(w.y << 16); f[3] = __uint_as_float(w.y & 0xffff0000u);
    f[4] = __uint_as_float(w.z << 16); f[5] = __uint_as_float(w.z & 0xffff0000u); f[6] = __uint_as_float(w.w << 16); f[7] = __uint_as_float(w.w & 0xffff0000u); }
__device__ __forceinline__ v4u pack8(const float (&f)[8]) { v4u o; o.x = pk2(f[0], f[1]); o.y = pk2(f[2], f[3]); o.z = pk2(f[4], f[5]); o.w = pk2(f[6], f[7]); return o; }
__device__ __forceinline__ float wave_sum(float v) {
#pragma unroll
    for (int o = 1; o < 64; o <<= 1) v += __shfl_xor(v, o);
    return v;
}

struct KArgs { const float* in[15]; float* out; unsigned char* ws; };

template <bool WIN>
__device__ __forceinline__ void transpose_item(const float* W, int K, int N, bf16* WT, LAS float* scr, int item, int lane) {
    const int nblk = (N + 31) / 32, kb = item / nblk, nb = item % nblk, k0 = 64 * kb, n0 = 32 * nb;
    { const int n = n0 + (lane & 31); const bool ok = n < N;
      const float sc = (WIN && n >= 1536 && n < 2048) ? QSCALE : 1.f;
#pragma unroll 8
      for (int i = 0; i < 32; ++i) { const int kk = 2 * i + (lane >> 5); scr[kk * 33 + (lane & 31)] = ok ? W[(size_t)(k0 + kk) * N + n] * sc : 0.f; } }
    LDS_WAIT(); asm volatile("" ::: "memory");
    const int c = lane & 7;
#pragma unroll
    for (int j = 0; j < 4; ++j) { const int nl = (lane >> 3) + 8 * j, n = n0 + nl; const LAS float* s = scr + (8 * c) * 33 + nl;
        v4u o; o.x = pk2(s[0 * 33], s[1 * 33]); o.y = pk2(s[2 * 33], s[3 * 33]); o.z = pk2(s[4 * 33], s[5 * 33]); o.w = pk2(s[6 * 33], s[7 * 33]);
        int dr = n; if (WIN) dr = n < 2816 ? n : (n < 2840 ? n + 512 : n - 24);
        if (n < N) *(GAS v4u*)(WT + (size_t)dr * K + k0 + 8 * c) = o; }
    LDS_WAIT(); asm volatile("" ::: "memory");
}
__device__ __forceinline__ void row_to_bf16(const float* xrow, bf16* orow, int lane) {
    const GAS f32x4* xr = (const GAS f32x4*)xrow + lane; GAS unsigned long long* o8 = (GAS unsigned long long*)orow + lane;
#pragma unroll
    for (int j = 0; j < 4; ++j) { const f32x4 v = xr[64 * j]; o8[64 * j] = (unsigned long long)pk2(v.x, v.y) | ((unsigned long long)pk2(v.z, v.w) << 32); }
}
__device__ __forceinline__ int rel_bucket(int d) {
    if (d < 16) return d;
    return 16 + (d >= 19) + (d >= 21) + (d >= 24) + (d >= 27) + (d >= 31) + (d >= 35) + (d >= 40) + (d >= 46) + (d >= 52) + (d >= 59) + (d >= 67) + (d >= 77) + (d >= 87) + (d >= 99) + (d >= 113);
}
__device__ __forceinline__ void prologue(const KArgs& a, LAS unsigned char* lds, int gw, int NGW, int wave, int lane) {
    unsigned char* ws = a.ws;
    LAS float* scr = (LAS float*)(lds + wave * 16384);
    constexpr int I_WIN = 16 * 105, I_WOUT = 16 * 32, I_W1 = 32 * 4, I_W2 = 2 * 2, I_PW = 1 * 2;
    constexpr int N_WIN = 2 * I_WIN, N_WOUT = 2 * I_WOUT, N_W1 = 4 * I_W1, N_W2 = 4 * I_W2, N_PW = 8 * I_PW;
    constexpr int NITEMS = N_WIN + N_WOUT + N_W1 + N_W2 + N_PW;
    for (int it = gw; it < NITEMS; it += NGW) {
        int r = it;
        if (r < N_WIN) { const int l = r / I_WIN; transpose_item<true>(a.in[1] + (size_t)l * DM * DPROJ, DM, DPROJ, (bf16*)(ws + WS_WIN) + (size_t)l * NP * DM, scr, r % I_WIN, lane); continue; } r -= N_WIN;
        if (r < N_WOUT) { const int l = r / I_WOUT; transpose_item<false>(a.in[2] + (size_t)l * DM * DM, DM, DM, (bf16*)(ws + WS_WOUT) + (size_t)l * DM * DM, scr, r % I_WOUT, lane); continue; } r -= N_WOUT;
        if (r < N_W1) { const int idx = r / I_W1, l = idx >> 1; const float* src = (idx & 1) ? a.in[10] : a.in[7];
            transpose_item<false>(src + (size_t)l * 2048 * 128, 2048, 128, (bf16*)(ws + WS_W1T) + (size_t)idx * 128 * 2048, scr, r % I_W1, lane); continue; } r -= N_W1;
        if (r < N_W2) { const int idx = r / I_W2, l = idx >> 1; const float* src = (idx & 1) ? a.in[11] : a.in[8];
            transpose_item<false>(src + (size_t)l * 128 * 64, 128, 64, (bf16*)(ws + WS_W2T) + (size_t)idx * 64 * 128, scr, r % I_W2, lane); continue; } r -= N_W2;
        { const int idx = r / I_PW; transpose_item<false>(a.in[3] + (size_t)idx * 64 * 64, 64, 64, (bf16*)(ws + WS_PWT) + (size_t)idx * 64 * 64, scr, r % I_PW, lane); }
    }
    for (int r = gw; r < 2 * (NP - DPROJ); r += NGW) {
        const int l = r / (NP - DPROJ), row = DPROJ + r % (NP - DPROJ);
        GAS v4u* p = (GAS v4u*)((bf16*)(ws + WS_WIN) + ((size_t)l * NP + row) * DM); const v4u z = {0u, 0u, 0u, 0u}; p[lane] = z; p[lane + 64] = z; }
    for (int m = gw; m < M; m += NGW) row_to_bf16(a.in[0] + (size_t)m * DM, (bf16*)(ws + WS_XB) + (size_t)m * DM, lane);
    if (gw == 0) { float* tbl = (float*)(ws + WS_TBL);
        for (int idx = lane; idx < 8 * 129; idx += 64) { const int h = idx / 129, dd = idx % 129; tbl[h * 132 + dd] = a.in[12][rel_bucket(dd) * 8 + h] * LOG2E; } }
}

__device__ __forceinline__ void poolconv_tile(int tile, int l, const KArgs& a, LAS unsigned char* lds, int tid) {
    const bf16* proj = (const bf16*)(a.ws + WS_PROJ); bf16* ymix = (bf16*)(a.ws + WS_YMIX);
    const bf16* PWT = (const bf16*)(a.ws + WS_PWT); const float* pscale = a.in[4] + l * 256; const float* convw = a.in[5] + l * 768;
    const int lane = tid & 63, wave = __builtin_amdgcn_readfirstlane(tid >> 6);
    const long m0 = (long)tile * 64; const int t0 = (int)(m0 % SEQ);
    LAS unsigned char* VT = lds; LAS unsigned char* PT = lds + 40960;
    for (int idx = tid; idx < 79 * 32; idx += 512) { const int rr = idx >> 5, ch = idx & 31, t = t0 - 15 + rr; v4u v = {0u, 0u, 0u, 0u};
        if (t >= 0) v = *(const v4u*)(proj + (size_t)(m0 - 15 + rr) * NP + C_POOLV + ch * 8);
        *(LAS v4u*)(VT + rr * 512 + ch * 16) = v; }
    __syncthreads();
#pragma unroll 1
    for (int k = 0; k < 4; ++k) { const int idx = tid + 512 * k, tl = idx >> 5, ch = idx & 31, gi = ch >> 3, w = 2 << gi, t = t0 + tl; const int nwin = w < t + 1 ? w : t + 1;
        float s[8] = {0.f, 0.f, 0.f, 0.f, 0.f, 0.f, 0.f, 0.f}, cur[8];
        { const v4u t_ = *(const LAS v4u*)(VT + (tl + 15) * 512 + ch * 16); unpack8(t_, cur); }
        for (int i = 0; i < nwin; ++i) { float f[8]; { const v4u t_ = *(const LAS v4u*)(VT + (tl + 15 - i) * 512 + ch * 16); unpack8(t_, f); }
#pragma unroll
            for (int e = 0; e < 8; ++e) s[e] += f[e]; }
        const float cntf = (float)nwin; float p[8];
#pragma unroll
        for (int e = 0; e < 8; ++e) p[e] = s[e] / cntf - cur[e];
        *(LAS v4u*)(PT + tl * 528 + ch * 16) = pack8(p); }
    __syncthreads();
    { const int gi = wave & 3, th = wave >> 2, fr = lane & 15, fq = lane >> 4;
      f32x4 acc[2][4];
#pragma unroll
      for (int rt = 0; rt < 2; ++rt)
#pragma unroll
          for (int ct = 0; ct < 4; ++ct) acc[rt][ct] = (f32x4){0.f, 0.f, 0.f, 0.f};
#pragma unroll
      for (int ks = 0; ks < 2; ++ks) { bf16x8 av[2], bv[4];
#pragma unroll
          for (int rt = 0; rt < 2; ++rt) av[rt] = *(const LAS bf16x8*)(PT + (th * 32 + rt * 16 + fr) * 528 + (gi * 64 + ks * 32 + 8 * fq) * 2);
#pragma unroll
          for (int ct = 0; ct < 4; ++ct) bv[ct] = *(const bf16x8*)(PWT + ((size_t)(l * 4 + gi) * 64 + ct * 16 + fr) * 64 + ks * 32 + 8 * fq);
#pragma unroll
          for (int rt = 0; rt < 2; ++rt)
#pragma unroll
              for (int ct = 0; ct < 4; ++ct) acc[rt][ct] = __builtin_amdgcn_mfma_f32_16x16x32_bf16(av[rt], bv[ct], acc[rt][ct], 0, 0, 0); }
#pragma unroll
      for (int rt = 0; rt < 2; ++rt)
#pragma unroll
          for (int ct = 0; ct < 4; ++ct) { const int col = gi * 64 + ct * 16 + fr; const float sc = pscale[col];
#pragma unroll
              for (int rg = 0; rg < 4; ++rg) { const int tl = th * 32 + rt * 16 + 4 * fq + rg; const size_t row = (size_t)(m0 + tl);
                  const float z = bf2f(proj[row * NP + C_POOLZ + col]);
                  ymix[row * DM + col] = (bf16)f2bf(silu(z) * (acc[rt][ct][rg] * sc)); } } }
#pragma unroll 1
    for (int k = 0; k < 4; ++k) { const int idx = tid + 512 * k, tl = idx >> 5, ch = idx & 31, col = ch * 8, t = t0 + tl; const size_t row = (size_t)(m0 + tl);
        const bf16* pr = proj + row * NP + col; const v4u z4 = {0u, 0u, 0u, 0u};
        float fb[8], fz[8], c0[8], x0[8], c1[8], x1[8], c2[8], x2[8];
        unpack8(*(const v4u*)(pr + C_CONVB), fb); unpack8(*(const v4u*)(pr + C_CONVZ), fz);
        unpack8(*(const v4u*)(pr + C_CONVC), c0); unpack8(*(const v4u*)(pr + C_CONVX), x0);
        unpack8(t >= 1 ? *(const v4u*)(pr - NP + C_CONVC) : z4, c1); unpack8(t >= 1 ? *(const v4u*)(pr - NP + C_CONVX) : z4, x1);
        unpack8(t >= 2 ? *(const v4u*)(pr - 2 * NP + C_CONVC) : z4, c2); unpack8(t >= 2 ? *(const v4u*)(pr - 2 * NP + C_CONVX) : z4, x2);
        float o[8];
#pragma unroll
        for (int e = 0; e < 8; ++e) { const float y = convw[col + e] * (c2[e] * x2[e]) + convw[256 + col + e] * (c1[e] * x1[e]) + convw[512 + col + e] * (c0[e] * x0[e]);
            o[e] = fb[e] * y * silu(fz[e]); }
        *(v4u*)(ymix + row * DM + 256 + col) = pack8(o); }
    __syncthreads();
}

__device__ __forceinline__ void compress_task(int task, int l, const KArgs& a, LAS unsigned char* scr, int lane) {
    const bf16* proj = (const bf16*)(a.ws + WS_PROJ);
    const int kv = task & 1, bg = (task >> 1) & 7, nt = task >> 4, b = bg >> 1, g = bg & 1;
    const float* pe = (kv ? a.in[9] : a.in[6]) + l * 32 * 64;
    const bf16* w1 = (const bf16*)(a.ws + WS_W1T) + (size_t)(l * 2 + kv) * 128 * 2048; const bf16* w2 = (const bf16*)(a.ws + WS_W2T) + (size_t)(l * 2 + kv) * 64 * 128;
    const int ccol = (kv ? C_VCMP : C_KCMP) + g * 64, fr = lane & 15, fq = lane >> 4, n = nt * 16 + fr;
    f32x4 acc[8];
#pragma unroll
    for (int ct = 0; ct < 8; ++ct) acc[ct] = (f32x4){0.f, 0.f, 0.f, 0.f};
#pragma unroll 2
    for (int ks = 0; ks < 64; ++ks) { const int lpos = ks >> 1, d = (ks & 1) * 32 + 8 * fq; int trow = 16 * n + lpos; trow = trow < SEQ ? trow : SEQ - 1;
        float f[8]; unpack8(*(const v4u*)(proj + ((size_t)b * SEQ + trow) * NP + ccol + d), f);
        const f32x4 pe0 = *(const f32x4*)(pe + lpos * 64 + d), pe1 = *(const f32x4*)(pe + lpos * 64 + d + 4);
        f[0] += pe0.x; f[1] += pe0.y; f[2] += pe0.z; f[3] += pe0.w; f[4] += pe1.x; f[5] += pe1.y; f[6] += pe1.z; f[7] += pe1.w;
        const bf16x8 av = __builtin_bit_cast(bf16x8, pack8(f));
#pragma unroll
        for (int ct = 0; ct < 8; ++ct) { const bf16x8 bv = *(const bf16x8*)(w1 + (size_t)(ct * 16 + fr) * 2048 + ks * 32 + 8 * fq); acc[ct] = __builtin_amdgcn_mfma_f32_16x16x32_bf16(av, bv, acc[ct], 0, 0, 0); } }
#pragma unroll
    for (int ct = 0; ct < 8; ++ct)
#pragma unroll
        for (int rg = 0; rg < 4; ++rg) *(LAS unsigned short*)(scr + (4 * fq + rg) * 272 + (ct * 16 + fr) * 2) = (unsigned short)f2bf(silu(acc[ct][rg]));
    LDS_WAIT(); asm volatile("" ::: "memory");
    f32x4 acc2[4];
#pragma unroll
    for (int ct = 0; ct < 4; ++ct) acc2[ct] = (f32x4){0.f, 0.f, 0.f, 0.f};
#pragma unroll
    for (int ks = 0; ks < 4; ++ks) { const bf16x8 av = *(const LAS bf16x8*)(scr + fr * 272 + (ks * 32 + 8 * fq) * 2);
#pragma unroll
        for (int ct = 0; ct < 4; ++ct) { const bf16x8 bv = *(const bf16x8*)(w2 + (size_t)(ct * 16 + fr) * 128 + ks * 32 + 8 * fq); acc2[ct] = __builtin_amdgcn_mfma_f32_16x16x32_bf16(av, bv, acc2[ct], 0, 0, 0); } }
    bf16* dst = (bf16*)(a.ws + (kv ? WS_VC : WS_KC)) + ((size_t)(b * 2 + g) * NCMP_PAD + nt * 16) * 64;
#pragma unroll
    for (int ct = 0; ct < 4; ++ct)
#pragma unroll
        for (int rg = 0; rg < 4; ++rg) dst[(4 * fq + rg) * 64 + ct * 16 + fr] = (bf16)f2bf(acc2[ct][rg]);
    LDS_WAIT(); asm volatile("" ::: "memory");
}

__device__ __forceinline__ void ln_row(const float* vrow, const float* gam, const float* bet, float* orow, bf16* xbrow, int lane) {
    const GAS f32x4* xr = (const GAS f32x4*)vrow + lane;
    f32x4 v[4]; float s = 0.f;
#pragma unroll
    for (int j = 0; j < 4; ++j) { v[j] = xr[64 * j]; s += (v[j].x + v[j].y) + (v[j].z + v[j].w); }
    const float mean = wave_sum(s) * (1.f / DM); float s2 = 0.f;
#pragma unroll
    for (int j = 0; j < 4; ++j) { v[j] = v[j] - mean; s2 += (v[j].x * v[j].x + v[j].y * v[j].y) + (v[j].z * v[j].z + v[j].w * v[j].w); }
    const float rstd = 1.f / sqrtf(wave_sum(s2) * (1.f / DM) + LN_EPS);
#pragma unroll
    for (int j = 0; j < 4; ++j) { const f32x4 gg = ((const f32x4*)gam)[lane + 64 * j], bb = ((const f32x4*)bet)[lane + 64 * j]; const f32x4 o = v[j] * rstd * gg + bb;
        ((GAS f32x4*)orow)[lane + 64 * j] = o;
        if (xbrow) ((GAS unsigned long long*)xbrow)[lane + 64 * j] = (unsigned long long)pk2(o.x, o.y) | ((unsigned long long)pk2(o.z, o.w) << 32); }
}

namespace nsa {
typedef __attribute__((address_space(3))) unsigned char lds_t;
typedef __attribute__((address_space(3))) float lds_f;
typedef __attribute__((address_space(3))) unsigned lds_u;
using bf16x8 = __attribute__((ext_vector_type(8))) short;
using s16x4 = __attribute__((ext_vector_type(4))) short;
using f32x16 = __attribute__((ext_vector_type(16))) float;
using u32x4 = __attribute__((ext_vector_type(4))) unsigned;
using f32x4 = __attribute__((ext_vector_type(4))) float;
typedef short v4i16_t __attribute__((ext_vector_type(4)));
constexpr int L_K = 0, L_V = 16384, L_IMP = 32768, L_SEL = 65536, L_WS = 66560, L_TBL = 68608, L_END = 70720, L_OST = 73728;
constexpr float NEG2 = -2e30f, MINIT = -1e30f;
constexpr int NSEL_FREE = 13;

__device__ __forceinline__ int crow(int r, int hi) { return (r & 3) + 8 * (r >> 2) + 4 * hi; }
__device__ __forceinline__ unsigned cvtpk(float lo, float hi) { typedef float f2_t __attribute__((ext_vector_type(2))); typedef __bf16 b2_t __attribute__((ext_vector_type(2)));
    f2_t v = {lo, hi}; b2_t b = __builtin_convertvector(v, b2_t); return __builtin_bit_cast(unsigned, b); }
__device__ __forceinline__ float halfmax(float v) { auto rr = __builtin_amdgcn_permlane32_swap(__float_as_uint(v), __float_as_uint(v), false, false); return fmaxf(__uint_as_float(rr[0]), __uint_as_float(rr[1])); }
__device__ __forceinline__ float halfsum(float v) { auto rr = __builtin_amdgcn_permlane32_swap(__float_as_uint(v), __float_as_uint(v), false, false); return __uint_as_float(rr[0]) + __uint_as_float(rr[1]); }
__device__ __forceinline__ s16x4 vtr(const lds_t* p) { return __builtin_bit_cast(s16x4, __builtin_amdgcn_ds_read_tr16_b64_v4i16((__attribute__((address_space(3))) v4i16_t*)p)); }

__device__ __forceinline__ void qkt(f32x16& p0, f32x16& p1, const lds_t* kslot, const bf16x8 (&qr)[4], int c, int hi) {
    const lds_t* kb = kslot + hi * 1024 + c * 16;
#pragma unroll
    for (int r = 0; r < 16; ++r) { p0[r] = 0.f; p1[r] = 0.f; }
#pragma unroll
    for (int d0 = 0; d0 < 4; ++d0) {
        const bf16x8 b0 = *(const __attribute__((address_space(3))) bf16x8*)(kb + d0 * 2048);
        const bf16x8 b1 = *(const __attribute__((address_space(3))) bf16x8*)(kb + d0 * 2048 + 512);
        p0 = __builtin_amdgcn_mfma_f32_32x32x16_bf16(b0, qr[d0], p0, 0, 0, 0);
        p1 = __builtin_amdgcn_mfma_f32_32x32x16_bf16(b1, qr[d0], p1, 0, 0, 0); }
}
__device__ __forceinline__ void pv(f32x16 (&o)[2], const lds_t* vp, const f32x16& p0, const f32x16& p1) {
    u32x4 pw[4];
#pragma unroll
    for (int i = 0; i < 4; ++i) { pw[0][i] = cvtpk(p0[2 * i], p0[2 * i + 1]); pw[1][i] = cvtpk(p0[8 + 2 * i], p0[9 + 2 * i]); pw[2][i] = cvtpk(p1[2 * i], p1[2 * i + 1]); pw[3][i] = cvtpk(p1[8 + 2 * i], p1[9 + 2 * i]); }
#pragma unroll
    for (int d0 = 0; d0 < 2; ++d0)
#pragma unroll
        for (int ks = 0; ks < 4; ++ks) {
            const s16x4 lo = vtr(vp + d0 * 4096 + ks * 1024), hh = vtr(vp + d0 * 4096 + ks * 1024 + 512);
            const bf16x8 vf = {lo[0], lo[1], lo[2], lo[3], hh[0], hh[1], hh[2], hh[3]};
            o[d0] = __builtin_amdgcn_mfma_f32_32x32x16_bf16(__builtin_bit_cast(bf16x8, pw[ks]), vf, o[d0], 0, 0, 0); }
}
template <int MODE, bool GEN>
__device__ __forceinline__ void score_xform(f32x16& p0, f32x16& p1, int tile, int tq, bool sel, float cfar, const lds_f* tblh, int hi) {
    if (!GEN) {
#pragma unroll
        for (int r = 0; r < 16; ++r) { p0[r] = (MODE != 2 || sel) ? p0[r] + cfar : NEG2; p1[r] = (MODE != 2 || sel) ? p1[r] + cfar : NEG2; }
    } else {
        const int db = (MODE == 1) ? tq - 1024 * tile - 31 : tq - 64 * tile;
        constexpr int KS = (MODE == 1) ? 16 : 1;
#pragma unroll
        for (int r = 0; r < 16; ++r) { const int d0 = db - KS * crow(r, hi), d1 = d0 - 32 * KS;
            const int i0 = d0 < 0 ? 0 : (d0 > 128 ? 128 : d0), i1 = d1 < 0 ? 0 : (d1 > 128 ? 128 : d1);
            const float b0 = tblh[i0], b1 = tblh[i1];
            const bool v0 = d0 >= 0 && (MODE == 1 || (MODE == 2 ? sel : d0 < 512)), v1 = d1 >= 0 && (MODE == 1 || (MODE == 2 ? sel : d1 < 512));
            p0[r] = v0 ? p0[r] + b0 : NEG2; p1[r] = v1 ? p1[r] + b1 : NEG2; }
    }
}
template <bool WITH_O>
__device__ __forceinline__ void softmax_step(f32x16& p0, f32x16& p1, float& m, float& l, f32x16 (&o)[2], lds_f* wsf, int c, int hi) {
    float tm = fmaxf(p0[0], p1[0]);
#pragma unroll
    for (int r = 1; r < 16; ++r) tm = fmaxf(tm, fmaxf(p0[r], p1[r]));
    tm = halfmax(tm);
    if (__any(tm > m)) {
        const float mn = fmaxf(m, tm), alpha = ex2(m - mn); m = mn; l *= alpha;
        if (WITH_O) {
            if (hi == 0) wsf[c] = alpha;
            asm volatile("" ::: "memory");
#pragma unroll
            for (int r = 0; r < 16; ++r) { const float al = wsf[crow(r, hi)]; o[0][r] *= al; o[1][r] *= al; }
            asm volatile("" ::: "memory");
        }
    }
    float s = 0.f;
#pragma unroll
    for (int r = 0; r < 16; ++r) { p0[r] = ex2(p0[r] - m); p1[r] = ex2(p1[r] - m); s += p0[r] + p1[r]; }
    l += s;
}
template <bool FIRST>
__device__ __forceinline__ void accum_scaled(lds_f* ost, const f32x16 (&o)[2], float coef, lds_f* wsf, int c, int hi) {
    if (hi == 0) wsf[32 + c] = coef;
    asm volatile("" ::: "memory");
#pragma unroll
    for (int r = 0; r < 16; ++r) { const int orow = crow(r, hi); const float al = wsf[32 + orow];
        if (FIRST) { ost[orow * 64 + c] = al * o[0][r]; ost[orow * 64 + 32 + c] = al * o[1][r]; }
        else { ost[orow * 64 + c] += al * o[0][r]; ost[orow * 64 + 32 + c] += al * o[1][r]; } }
    asm volatile("" ::: "memory");
}

template <int MODE, bool GEN, int KIND>
__device__ __forceinline__ void run_tiles(int jb, int je, const unsigned short* ksrc, const unsigned short* vsrc, size_t stride, lds_t* lds, unsigned kst, unsigned vst, const lds_t* vlane,
                                          const bf16x8 (&qr)[4], float& m, float& l, f32x16 (&o)[2], int tq, unsigned long long sel_lo, unsigned long long sel_hi, float cfar, const lds_f* tblh,
                                          lds_f* wsf, lds_f* iq, float inv1, bool do_imp, int c, int hi, int hh) {
    if (jb >= je) return;
    constexpr bool HASV = KIND != 1;
    typedef __attribute__((address_space(3))) u32x4 lds_u4;
    u32x4 kreg, vreg = {0u, 0u, 0u, 0u};
    kreg = *(const u32x4*)(ksrc + (size_t)jb * stride); if (HASV) vreg = *(const u32x4*)(vsrc + (size_t)jb * stride);
    *(lds_u4*)(lds + L_K + (jb & 1) * 8192 + kst) = kreg; if (HASV) *(lds_u4*)(lds + L_V + (jb & 1) * 8192 + vst) = vreg;
    __syncthreads();
#pragma unroll 1
    for (int j = jb; j < je; ++j) {
        if (j + 1 < je) { kreg = *(const u32x4*)(ksrc + (size_t)(j + 1) * stride); if (HASV) vreg = *(const u32x4*)(vsrc + (size_t)(j + 1) * stride); }
        bool sel = true;
        if (MODE == 2) sel = (((j < 64 ? sel_lo : sel_hi) >> (j & 63)) & 1ull) != 0ull;
        if (MODE != 2 || __any(sel)) {
            f32x16 p0, p1;
            qkt(p0, p1, lds + L_K + (j & 1) * 8192, qr, c, hi);
            score_xform<MODE, GEN>(p0, p1, j, tq, sel, cfar, tblh, hi);
            if (KIND == 0) { softmax_step<true>(p0, p1, m, l, o, wsf, c, hi); pv(o, vlane + (j & 1) * 8192, p0, p1); }
            else if (KIND == 1) { softmax_step<false>(p0, p1, m, l, o, wsf, c, hi); }
            else {
#pragma unroll
                for (int r = 0; r < 16; ++r) { p0[r] = ex2(p0[r] - m) * inv1; p1[r] = ex2(p1[r] - m) * inv1; }
                if (do_imp) {
#pragma unroll
                    for (int q4 = 0; q4 < 4; ++q4) {
                        float a0 = 2.f * (p0[4 * q4] + p0[4 * q4 + 1] + p0[4 * q4 + 2]) + p0[4 * q4 + 3], b0 = p0[4 * q4 + 3];
                        float a1 = 2.f * (p1[4 * q4] + p1[4 * q4 + 1] + p1[4 * q4 + 2]) + p1[4 * q4 + 3], b1 = p1[4 * q4 + 3];
                        a0 += __shfl_xor(a0, 1); a0 += __shfl_xor(a0, 2); b0 += __shfl_xor(b0, 1); b0 += __shfl_xor(b0, 2);
                        a1 += __shfl_xor(a1, 1); a1 += __shfl_xor(a1, 2); b1 += __shfl_xor(b1, 1); b1 += __shfl_xor(b1, 2);
                        if (hh == 0) { const int j0 = 16 * j + 2 * q4 + hi, j1 = j0 + 8;
                            __hip_atomic_fetch_add(iq + j0, a0, __ATOMIC_RELAXED, __HIP_MEMORY_SCOPE_WORKGROUP); __hip_atomic_fetch_add(iq + j0 + 1, b0, __ATOMIC_RELAXED, __HIP_MEMORY_SCOPE_WORKGROUP);
                            __hip_atomic_fetch_add(iq + j1, a1, __ATOMIC_RELAXED, __HIP_MEMORY_SCOPE_WORKGROUP); if (j1 + 1 < 128) __hip_atomic_fetch_add(iq + j1 + 1, b1, __ATOMIC_RELAXED, __HIP_MEMORY_SCOPE_WORKGROUP); }
                    }
                }
                pv(o, vlane + (j & 1) * 8192, p0, p1);
            }
        }
        if (j + 1 < je) { *(lds_u4*)(lds + L_K + ((j + 1) & 1) * 8192 + kst) = kreg; if (HASV) *(lds_u4*)(lds + L_V + ((j + 1) & 1) * 8192 + vst) = vreg; }
        __syncthreads();
    }
}

__device__ __forceinline__ void nsa_unit(int b, int g, int jq, const KArgs& a, lds_t* lds, int tid) {
    const unsigned short* proj = (const unsigned short*)(a.ws + WS_PROJ);
    const float* tblG = (const float*)(a.ws + WS_TBL);
    const int lane = tid & 63, c = lane & 31, hi = lane >> 5;
    const int wid = __builtin_amdgcn_readfirstlane(tid >> 6);
    const int ql = c >> 2, hh = c & 3, head = 4 * g + hh;
    const int t0 = jq * 64, tw0 = t0 + 8 * wid, tq = tw0 + ql;
    const size_t rowbase = (size_t)b * SEQ;
    const int skey = tid >> 3, sch = tid & 7;
    const unsigned kst = sch * 1024 + skey * 16, vst = (sch >> 2) * 4096 + (skey >> 4) * 1024 + (skey & 15) * 64 + (sch & 3) * 16;
    lds_f* wsf = (lds_f*)(lds + L_WS) + wid * 64;
    lds_f* tbl = (lds_f*)(lds + L_TBL); const lds_f* tblh = tbl + hh * 132;
    lds_f* imp = (lds_f*)(lds + L_IMP); lds_u* selm = (lds_u*)(lds + L_SEL);
    lds_f* ost = (lds_f*)(lds + L_OST) + wid * 2048;
    const lds_t* vlane = lds + L_V + ((lane >> 4) & 1) * 32 + (lane & 3) * 8 + (4 * hi + ((lane & 15) >> 2)) * 64;

    for (int i = tid; i < 64 * 128 / 4; i += 512) ((__attribute__((address_space(3))) f32x4*)imp)[i] = (f32x4){0.f, 0.f, 0.f, 0.f};
    for (int i = tid; i < 4 * 132; i += 512) tbl[i] = tblG[g * 4 * 132 + i];
    bf16x8 qr[4];
    { const unsigned short* qb = proj + (rowbase + tq) * NP + C_Q + head * 64 + hi * 8;
#pragma unroll
      for (int d0 = 0; d0 < 4; ++d0) qr[d0] = *(const bf16x8*)(qb + d0 * 16); }
    const float cfar = tblG[head * 132 + 128];
    f32x16 o[2];
#define NSA_ZERO_O() do { _Pragma("unroll") for (int r_ = 0; r_ < 16; ++r_) { o[0][r_] = 0.f; o[1][r_] = 0.f; } } while (0)

    {
        const unsigned short* KC = (const unsigned short*)(a.ws + WS_KC) + (size_t)(b * 2 + g) * NCMP_PAD * 64 + tid * 8;
        const unsigned short* VC = (const unsigned short*)(a.ws + WS_VC) + (size_t)(b * 2 + g) * NCMP_PAD * 64 + tid * 8;
        int nt1 = (4 * jq + 3 + 63) >> 6; nt1 = nt1 < 8 ? nt1 : 8;
        int nfar = t0 >= 1167 ? ((t0 - 1167) >> 10) + 1 : 0; nfar = nfar < nt1 ? nfar : nt1;
        float m1 = MINIT, l1 = 0.f;
        run_tiles<1, false, 1>(0, nfar, KC, VC, 4096, lds, kst, vst, vlane, qr, m1, l1, o, tq, 0ull, 0ull, cfar, tblh, wsf, nullptr, 0.f, false, c, hi, hh);
        run_tiles<1, true, 1>(nfar, nt1, KC, VC, 4096, lds, kst, vst, vlane, qr, m1, l1, o, tq, 0ull, 0ull, cfar, tblh, wsf, nullptr, 0.f, false, c, hi, hh);
        l1 = halfsum(l1);
        const float inv1 = l1 > 0.f ? 1.f / l1 : 0.f;
        lds_f* iq = imp + (8 * wid + ql) * 128;
        NSA_ZERO_O();
        run_tiles<1, false, 2>(0, nfar, KC, VC, 4096, lds, kst, vst, vlane, qr, m1, l1, o, tq, 0ull, 0ull, cfar, tblh, wsf, iq, inv1, jq >= 16, c, hi, hh);
        run_tiles<1, true, 2>(nfar, nt1, KC, VC, 4096, lds, kst, vst, vlane, qr, m1, l1, o, tq, 0ull, 0ull, cfar, tblh, wsf, iq, inv1, jq >= 16, c, hi, hh);
        const float gate1 = sigm(bf2f(proj[(rowbase + tq) * NP + C_GATE + head * 3 + 0]));
        accum_scaled<true>(ost, o, gate1, wsf, c, hi);
    }
    if (jq >= 16) {
#pragma unroll 1
        for (int qi = 0; qi < 8; ++qi) {
            const lds_f* iqq = imp + (8 * wid + qi) * 128;
            const int j0 = lane, j1 = lane + 64;
            const bool c0 = j0 >= 1 && j0 <= jq - 2, c1 = j1 <= jq - 2;
            const unsigned k0 = c0 ? __float_as_uint(iqq[j0]) + 1u : 0u, k1 = c1 ? __float_as_uint(iqq[j1]) + 1u : 0u;
            unsigned prefix = 0u;
#pragma unroll 1
            for (int bit = 30; bit >= 0; --bit) { const unsigned cand = prefix | (1u << bit);
                const int cnt = __popcll(__ballot(k0 >= cand)) + __popcll(__ballot(k1 >= cand));
                if (cnt >= NSEL_FREE) prefix = cand; }
            const unsigned long long gt0 = __ballot(k0 > prefix), gt1 = __ballot(k1 > prefix), eq0 = __ballot(k0 == prefix), eq1 = __ballot(k1 == prefix);
            const int need = NSEL_FREE - (__popcll(gt0) + __popcll(gt1));
            const unsigned long long lt = (1ull << lane) - 1ull;
            const bool s0 = (k0 > prefix) || (k0 == prefix && __popcll(eq0 & lt) < need);
            const bool s1 = (k1 > prefix) || (k1 == prefix && (__popcll(eq0) + __popcll(eq1 & lt)) < need);
            unsigned long long b0 = __ballot(s0), b1 = __ballot(s1);
            b0 |= 1ull;
            if (jq < 64) b0 |= 1ull << jq; else b1 |= 1ull << (jq - 64);
            if (jq - 1 < 64) b0 |= 1ull << (jq - 1); else b1 |= 1ull << (jq - 65);
            if (lane == 0) { lds_u* sp = selm + (8 * wid + qi) * 4; sp[0] = (unsigned)b0; sp[1] = (unsigned)(b0 >> 32); sp[2] = (unsigned)b1; sp[3] = (unsigned)(b1 >> 32); }
        }
    } else {
        if (lane < 8) { lds_u* sp = selm + (8 * wid + lane) * 4; sp[0] = (2u << jq) - 1u; sp[1] = 0u; sp[2] = 0u; sp[3] = 0u; }
    }
    asm volatile("" ::: "memory");
    unsigned long long sel_lo, sel_hi;
    { const lds_u* sp = selm + (8 * wid + ql) * 4; sel_lo = (unsigned long long)sp[0] | ((unsigned long long)sp[1] << 32); sel_hi = (unsigned long long)sp[2] | ((unsigned long long)sp[3] << 32); }

    const int jn = jq >= 2 ? jq - 2 : 0;
    {
        float m2 = MINIT, l2 = 0.f; NSA_ZERO_O();
        const unsigned short* ks = proj + (rowbase + skey) * NP + C_KSLC + g * 64 + sch * 8; const unsigned short* vs = proj + (rowbase + skey) * NP + C_VSLC + g * 64 + sch * 8;
        run_tiles<2, false, 0>(0, jn, ks, vs, (size_t)64 * NP, lds, kst, vst, vlane, qr, m2, l2, o, tq, sel_lo, sel_hi, cfar, tblh, wsf, nullptr, 0.f, false, c, hi, hh);
        run_tiles<2, true, 0>(jn, jq + 1, ks, vs, (size_t)64 * NP, lds, kst, vst, vlane, qr, m2, l2, o, tq, sel_lo, sel_hi, cfar, tblh, wsf, nullptr, 0.f, false, c, hi, hh);
        l2 = halfsum(l2);
        const float gate2 = sigm(bf2f(proj[(rowbase + tq) * NP + C_GATE + head * 3 + 1]));
        accum_scaled<false>(ost, o, l2 > 0.f ? gate2 / l2 : 0.f, wsf, c, hi);
    }
    {
        float m3 = MINIT, l3 = 0.f; NSA_ZERO_O();
        const unsigned short* ks = proj + (rowbase + skey) * NP + C_KWIN + g * 64 + sch * 8; const unsigned short* vs = proj + (rowbase + skey) * NP + C_VWIN + g * 64 + sch * 8;
        const int jf = jq >= 7 ? jq - 7 : 0;
        if (jq >= 8) run_tiles<3, true, 0>(jq - 8, jq - 7, ks, vs, (size_t)64 * NP, lds, kst, vst, vlane, qr, m3, l3, o, tq, 0ull, 0ull, cfar, tblh, wsf, nullptr, 0.f, false, c, hi, hh);
        run_tiles<3, false, 0>(jf, jn, ks, vs, (size_t)64 * NP, lds, kst, vst, vlane, qr, m3, l3, o, tq, 0ull, 0ull, cfar, tblh, wsf, nullptr, 0.f, false, c, hi, hh);
        run_tiles<3, true, 0>(jn, jq + 1, ks, vs, (size_t)64 * NP, lds, kst, vst, vlane, qr, m3, l3, o, tq, 0ull, 0ull, cfar, tblh, wsf, nullptr, 0.f, false, c, hi, hh);
        l3 = halfsum(l3);
        const float gate3 = sigm(bf2f(proj[(rowbase + tq) * NP + C_GATE + head * 3 + 2]));
        accum_scaled<false>(ost, o, l3 > 0.f ? gate3 / l3 : 0.f, wsf, c, hi);
    }
    {
        unsigned short* ymix = (unsigned short*)(a.ws + WS_YMIX);
        asm volatile("s_waitcnt lgkmcnt(0)" ::: "memory");
#pragma unroll
        for (int i = 0; i < 8; ++i) { const int row = i * 4 + (lane >> 4), ch = lane & 15;
            const f32x4 v = *(const __attribute__((address_space(3))) f32x4*)(ost + row * 64 + ch * 4);
            const size_t tok = rowbase + tw0 + (row >> 2); const int hd = 4 * g + (row & 3);
            const uint2 z = *(const uint2*)(proj + tok * NP + C_NSAZ + hd * 64 + ch * 4);
            const float z0 = __uint_as_float(z.x << 16), z1 = __uint_as_float(z.x & 0xffff0000u), z2 = __uint_as_float(z.y << 16), z3 = __uint_as_float(z.y & 0xffff0000u);
            uint2 w; w.x = pk2(v.x * silu(z0), v.y * silu(z1)); w.y = pk2(v.z * silu(z2), v.w * silu(z3));
            *(uint2*)(ymix + tok * DM + 512 + hd * 64 + ch * 4) = w; }
        __syncthreads();
    }
#undef NSA_ZERO_O
}
}

__device__ __forceinline__ int opaque_v(int x) { asm volatile("" : "+v"(x)); return x; }
__device__ __forceinline__ int opaque_s(int x) { asm volatile("" : "+s"(x)); return x; }
struct Ids { int tid, lane, wave, G, bx, vcu, gw, NGW; };
__device__ __forceinline__ const KArgs& kargs() { auto p = __builtin_amdgcn_kernarg_segment_ptr(); asm volatile("" : "+s"(p)); return *(const KArgs*)p; }
__device__ __forceinline__ Ids make_ids() {
    Ids d; d.tid = opaque_v((int)threadIdx.x); d.lane = d.tid & 63; d.wave = __builtin_amdgcn_readfirstlane(d.tid >> 6);
    d.G = opaque_s((int)gridDim.x); d.bx = opaque_s((int)blockIdx.x); d.vcu = (d.G % 8 == 0) ? (d.bx % 8) * (d.G / 8) + d.bx / 8 : d.bx;
    d.gw = d.vcu * NWAVES + d.wave; d.NGW = d.G * NWAVES; return d;
}
__global__ void __launch_bounds__(NWAVES * 64, 2) fwd_kernel(KArgs a_unused) {
    extern __shared__ __attribute__((aligned(16))) unsigned char lds_raw[];
    LAS unsigned char* lds = (LAS unsigned char*)lds_raw;
    volatile LAS unsigned* MISC = (volatile LAS unsigned*)(lds + MISC_OFF);
    for (int u = threadIdx.x; u < (LDS_BYTES - LDSCTL_OFF) / 4; u += NWAVES * 64) ((LAS unsigned*)(lds + LDSCTL_OFF))[u] = 0u;
    __syncthreads();
    XcdBarrier bar = xcd_barrier_post((unsigned*)(kargs().ws + WS_CTL) + CW_BAR, MISC + 8);

    { const Ids d = make_ids(); const KArgs& a = kargs(); prologue(a, lds, d.gw, d.NGW, d.wave, d.lane); }
    xcd_barrier(bar);

#pragma unroll 1
    for (int l = 0; l < DEPTH; ++l) {
#ifndef SKIP_A
        { const Ids d = make_ids(); const KArgs& a = kargs(); unsigned char* ws = a.ws;
          pg8::Gemm g{(const pg8::bf16_t*)(ws + WS_XB), (const pg8::bf16_t*)(ws + WS_WIN) + (size_t)l * NP * DM, M, NP, DM}; pg8::StaticOrder S; S.init(M, NP, d.G, d.bx);
          pg8::EpiBf16 E{(pg8::bf16_t*)(ws + WS_PROJ), NP};
          pg8::gemm_phase<pg8::EpiBf16, pg8::StaticOrder, true, true>(lds, g, S, E); }
#endif
        xcd_barrier(bar);
        { const Ids d = make_ids(); const KArgs& a = kargs();
#ifndef SKIP_B1
#pragma unroll 1
          for (int tile = d.vcu; tile < M / 64; tile += d.G) poolconv_tile(tile, l, a, lds, d.tid);
#endif
#ifndef SKIP_B2
          if (d.wave < 2) {
#pragma unroll 1
              for (int task = d.vcu * 2 + d.wave; task < 512; task += 2 * d.G) compress_task(task, l, a, lds + d.wave * 8192, d.lane); }
#endif
        }
        xcd_barrier(bar);
#ifndef SKIP_C
        { const Ids d = make_ids(); const KArgs& a = kargs(); const int nun = (d.G == 256) ? 4 : (1024 - d.vcu + d.G - 1) / d.G;
#pragma unroll 1
          for (int i = 0; i < nun; ++i) { int bg, jq;
              if (d.G == 256) { const int s = d.vcu & 31; bg = d.vcu >> 5; jq = (i == 0) ? 127 - s : (i == 1) ? 64 + s : (i == 2) ? 63 - s : s; }
              else { const int u = d.vcu + i * d.G; bg = u >> 7; jq = u & 127; }
              nsa::nsa_unit(bg >> 1, bg & 1, jq, a, (nsa::lds_t*)lds, d.tid); } }
#endif
        xcd_barrier(bar);
#ifndef SKIP_D
        { const Ids d = make_ids(); const KArgs& a = kargs(); unsigned char* ws = a.ws;
          pg8::Gemm g{(const pg8::bf16_t*)(ws + WS_YMIX), (const pg8::bf16_t*)(ws + WS_WOUT) + (size_t)l * DM * DM, M, DM, DM}; pg8::StaticOrder S; S.init(M, DM, d.G, d.bx);
          pg8::EpiResid E{l == 0 ? a.in[0] : a.out, (float*)(ws + WS_VBUF), DM, ALPHA};
          pg8::gemm_phase<pg8::EpiResid, pg8::StaticOrder, true, true>(lds, g, S, E); }
#endif
        xcd_barrier(bar);
        { const Ids d = make_ids(); const KArgs& a = kargs(); unsigned char* ws = a.ws; const float* gam = a.in[13] + l * DM; const float* bet = a.in[14] + l * DM;
#pragma unroll 1
          for (int m = d.gw; m < M; m += d.NGW) ln_row((const float*)(ws + WS_VBUF) + (size_t)m * DM, gam, bet, a.out + (size_t)m * DM, l + 1 < DEPTH ? (bf16*)(ws + WS_XB) + (size_t)m * DM : nullptr, d.lane); }
        if (l + 1 < DEPTH) xcd_barrier(bar);
    }
}

extern "C" void kernel_launch(void* const* d_in, const int* in_sizes, int n_in, void* d_out, int out_size, void* d_ws, size_t ws_size, hipStream_t stream) {
    static int grid = 0;
    if (grid == 0) {
        if (n_in != 15 || in_sizes[0] != M * DM || out_size != M * DM || ws_size < WS_END) { fprintf(stderr, "kernel_launch: unexpected shapes / workspace (n_in %d, in0 %d, out %d, ws %zu); nothing launched\n", n_in, n_in > 0 ? in_sizes[0] : -1, out_size, ws_size); grid = -1; return; }
        int dev = 0, cus = 0;
        if (hipGetDevice(&dev) != hipSuccess || hipDeviceGetAttribute(&cus, hipDeviceAttributeMultiprocessorCount, dev) != hipSuccess) { fprintf(stderr, "kernel_launch: device query failed\n"); grid = -1; return; }
        if (hipFuncSetAttribute((const void*)fwd_kernel, hipFuncAttributeMaxDynamicSharedMemorySize, LDS_BYTES) != hipSuccess) { fprintf(stderr, "kernel_launch: hipFuncSetAttribute failed\n"); grid = -1; return; }
        int per_cu = 0;
        if (hipOccupancyMaxActiveBlocksPerMultiprocessor(&per_cu, (const void*)fwd_kernel, NWAVES * 64, LDS_BYTES) != hipSuccess || per_cu < 1) fprintf(stderr, "kernel_launch: note: occupancy query reports %d workgroups per CU\n", per_cu);
        (void)hipGetLastError();
        grid = cus;
    }
    if (grid < 0) return;
    if (hipMemsetAsync((char*)d_ws + WS_CTL, 0, CTL_ZERO_BYTES, stream) != hipSuccess) { fprintf(stderr, "kernel_launch: hipMemsetAsync failed\n"); return; }
    KArgs a{};
    for (int i = 0; i < 15; ++i) a.in[i] = (const float*)d_in[i];
    a.out = (float*)d_out; a.ws = (unsigned char*)d_ws;
    hipLaunchKernelGGL(fwd_kernel, dim3(grid), dim3(NWAVES * 64), LDS_BYTES, stream, a);
    const hipError_t le = hipPeekAtLastError();
    if (le != hipSuccess) fprintf(stderr, "kernel_launch: launch failed: %s\n", hipGetErrorName(le));
}
```

```cpp
#include <hip/hip_runtime.h>
#include <hip/hip_bf16.h>
#include <cstdio>
#include <cstdint>
namespace pg8 {
#define PG8_LAS __attribute__((address_space(3)))
typedef unsigned short bf16_t;
typedef short bf16x8 __attribute__((ext_vector_type(8)));
typedef float f32x4 __attribute__((ext_vector_type(4)));
typedef unsigned u32x4 __attribute__((ext_vector_type(4)));
constexpr int BM = 256, BK = 64, HALF = 128, HTB = HALF * BK * 2  , STAGE_BYTES = 8 * HTB, NXCD = 8, WGM = 8;

__host__ __device__ __forceinline__ int lds_byte(int r, int c) { const int st = (r >> 4) * 2 + (c >> 5), rr = r & 15, cc = c & 31, ob = rr * 64 + cc * 2; return st * 1024 + (ob ^ (((ob >> 9) & 1) << 5)); }
__host__ __device__ __forceinline__ void stage_rc(int b, int& R, int& C) { const int st = b / 1024, sb = b % 1024, swz = sb ^ (((sb >> 9) & 1) << 5); R = (st >> 1) * 16 + swz / 64; C = (st & 1) * 32 + (swz % 64) / 2; }
__host__ __device__ __forceinline__ int perm32(int rho) { const int n = rho >> 4, i = rho & 15; return 8 * (i >> 2) + 4 * n + (i & 3); }

struct Unit { int pm, pn; };
struct Gemm { const bf16_t* A; const bf16_t* Bt; int M, N, K; };

struct StaticOrder {
    int nM, nN, nwg, G, c;
    __host__ __device__ void init(int M, int N, int G_, int c_) { nM = M / BM; nN = N / BM; nwg = nM * nN; G = G_; c = c_; }
    __host__ __device__ bool next(int i, Unit& u) const {
        const long L = (long)i * G + c; if (L >= nwg) return false;
        int wgid = (int)L; { const int q = nwg / NXCD, r = nwg % NXCD, xcd = wgid % NXCD, off = wgid / NXCD; wgid = (xcd < r ? xcd * (q + 1) : r * (q + 1) + (xcd - r) * q) + off; }
        const int nig = WGM * nN, gid = wgid / nig, fm = gid * WGM, gsz = (nM - fm) < WGM ? (nM - fm) : WGM;
        u.pm = fm + ((wgid % nig) % gsz); u.pn = (wgid % nig) / gsz; return true;
    }
    __device__ __forceinline__ void a_ready(const Unit&) const {}
    __device__ __forceinline__ void done(const Unit&) const {}
};
__device__ __forceinline__ unsigned cvt_pk_bf16(float lo, float hi) { unsigned r; asm volatile("v_cvt_pk_bf16_f32 %0, %1, %2" : "=v"(r) : "v"(lo), "v"(hi)); return r; }

struct EpiBf16 {
    static constexpr bool PERM = true, AFTER_DRAIN = false;
    bf16_t* O; int ldc;
    __device__ __forceinline__ void operator()(const f32x4 (&acc)[2][2][4][2], const Unit& u, int wr, int wc, int fr, int fq) const {
        const int row0 = u.pm * BM + wr * 64 + fr; const int col0 = u.pn * BM + wc * 32 + 8 * fq;
#pragma unroll
        for (int ai = 0; ai < 2; ++ai)
#pragma unroll
            for (int m = 0; m < 4; ++m) { bf16_t* rowp = O + (size_t)(row0 + ai * HALF + m * 16) * ldc + col0;
#pragma unroll
                for (int bj = 0; bj < 2; ++bj) { const f32x4 v0 = acc[ai][bj][m][0], v1 = acc[ai][bj][m][1];
                    u32x4 w; w.x = cvt_pk_bf16(v0[0], v0[1]); w.y = cvt_pk_bf16(v0[2], v0[3]); w.z = cvt_pk_bf16(v1[0], v1[1]); w.w = cvt_pk_bf16(v1[2], v1[3]);
                    *(u32x4*)(rowp + bj * HALF) = w; } }
    }
};
struct EpiResid {
    static constexpr bool PERM = false, AFTER_DRAIN = false;
    const float* base; float* out; int ldc; float alpha;
    __device__ __forceinline__ void operator()(const f32x4 (&acc)[2][2][4][2], const Unit& u, int wr, int wc, int fr, int fq) const {
        const int col0 = u.pn * BM + wc * 32 + 4 * fq;
#pragma unroll
        for (int ai = 0; ai < 2; ++ai)
#pragma unroll
            for (int m = 0; m < 4; ++m) { const size_t off = (size_t)(u.pm * BM + ai * HALF + wr * 64 + m * 16 + fr) * ldc + col0;
#pragma unroll
                for (int bj = 0; bj < 2; ++bj)
#pragma unroll
                    for (int n = 0; n < 2; ++n) { const f32x4 bs = *(const f32x4*)(base + off + bj * HALF + n * 16);
                        *(f32x4*)(out + off + bj * HALF + n * 16) = bs * alpha + acc[ai][bj][m][n]; } }
    }
};
template <class Epi, class Sched, bool ALIGN_EPI = false, bool SP2 = false>
__device__ __forceinline__ void gemm_phase(PG8_LAS unsigned char* lds, const Gemm g, const Sched& S, const Epi& E) {
    int tid_ = threadIdx.x; asm volatile("" : "+v"(tid_));
    const int tid = tid_, wid = __builtin_amdgcn_readfirstlane(tid >> 6), lane = tid & 63, wr = wid >> 2, wc = wid & 3, fr = lane & 15, fq = lane >> 4;
    const int K = g.K, nt = K / BK;
    unsigned voffA[2], voffB[2];
#pragma unroll
    for (int i = 0; i < 2; ++i) { int R, C; stage_rc(tid * 16 + i * 8192, R, C); const int Rb = Epi::PERM ? ((R & ~31) + perm32(R & 31)) : R;
        voffA[i] = (unsigned)(R * K + C) * 2u; voffB[i] = (unsigned)(Rb * K + C) * 2u; }
    const size_t kstep = (size_t)(BK * 2);
    const size_t hstep = (size_t)HALF * K * 2;
    const size_t tstep = 2 * hstep;
    const unsigned ldsw = (unsigned)wid * 1024u;
    const int aoff = lds_byte(wr * 64 + fr, fq * 8), boff = lds_byte(wc * 32 + fr, fq * 8);
#define PG8_SA(b, h) (((b) * 2 + (h)) * HTB)
#define PG8_SB(b, h) ((4 + (b) * 2 + (h)) * HTB)
#define PG8_STAGE(bufoff, gbase, voff) do { _Pragma("unroll") for (int _i = 0; _i < 2; ++_i) \
        __builtin_amdgcn_global_load_lds((const unsigned*)((const char*)(gbase) + (voff)[_i]), (PG8_LAS unsigned*)(lds + (bufoff) + ldsw + _i * 8192), 16, 0, 0); } while (0)
#define PG8_LDA(dst, b, h) do { _Pragma("unroll") for (int m = 0; m < 4; ++m) _Pragma("unroll") for (int k = 0; k < 2; ++k) dst[m][k] = *(const PG8_LAS bf16x8*)(lds + PG8_SA(b, h) + aoff + m * 2048 + k * 1024); } while (0)
#define PG8_LDB(dst, b, h) do { _Pragma("unroll") for (int n = 0; n < 2; ++n) _Pragma("unroll") for (int k = 0; k < 2; ++k) dst[n][k] = *(const PG8_LAS bf16x8*)(lds + PG8_SB(b, h) + boff + n * 2048 + k * 1024); } while (0)
#define PG8_MMA(ai, bj, At, Bt) do { __builtin_amdgcn_s_setprio(1); _Pragma("unroll") for (int m = 0; m < 4; ++m) _Pragma("unroll") for (int n = 0; n < 2; ++n) _Pragma("unroll") for (int k = 0; k < 2; ++k) \
        acc[ai][bj][m][n] = __builtin_amdgcn_mfma_f32_16x16x32_bf16(Bt[n][k], At[m][k], acc[ai][bj][m][n], 0, 0, 0); __builtin_amdgcn_s_setprio(0); } while (0)
#define PG8_WAIT_V(n) asm volatile("s_waitcnt vmcnt(" #n ")" ::: "memory")
#define PG8_WAIT_L(n) asm volatile("s_waitcnt lgkmcnt(" #n ")" ::: "memory")
#define PG8_BAR __builtin_amdgcn_s_barrier()
#define PG8_SCHED __builtin_amdgcn_sched_barrier(0)
    Unit cur, nxt; int ui = 0;
    if (!S.next(0, cur)) return;
    f32x4 acc[2][2][4][2];
#pragma unroll
    for (int a = 0; a < 2; ++a)
#pragma unroll
        for (int b = 0; b < 2; ++b)
#pragma unroll
            for (int m = 0; m < 4; ++m)
#pragma unroll
                for (int n = 0; n < 2; ++n) acc[a][b][m][n] = (f32x4){0.f, 0.f, 0.f, 0.f};
    bf16x8 At[4][2], B0[2][2], B1[2][2];
    const char* cA = (const char*)g.A + (size_t)cur.pm * tstep; const char* cB = (const char*)g.Bt + (size_t)cur.pn * tstep;
    S.a_ready(cur);
    if constexpr (SP2) {
        PG8_STAGE(PG8_SB(0, 0), cB, voffB); PG8_STAGE(PG8_SB(0, 1), cB + hstep, voffB); PG8_STAGE(PG8_SA(0, 0), cA, voffA); PG8_STAGE(PG8_SA(0, 1), cA + hstep, voffA);
        if (wr == 1) PG8_BAR;
        PG8_WAIT_V(2); PG8_BAR;
        PG8_STAGE(PG8_SB(1, 0), cB + kstep, voffB); PG8_STAGE(PG8_SA(1, 0), cA + kstep, voffA); PG8_STAGE(PG8_SB(1, 1), cB + hstep + kstep, voffB);
        PG8_WAIT_V(6); PG8_BAR;
    } else {
        PG8_STAGE(PG8_SB(0, 0), cB, voffB); PG8_STAGE(PG8_SA(0, 0), cA, voffA); PG8_STAGE(PG8_SB(0, 1), cB + hstep, voffB); PG8_STAGE(PG8_SA(0, 1), cA + hstep, voffA);
        if (wr == 1) PG8_BAR;
        PG8_WAIT_V(4); PG8_BAR;
        PG8_STAGE(PG8_SB(1, 0), cB + kstep, voffB); PG8_STAGE(PG8_SA(1, 0), cA + kstep, voffA); PG8_STAGE(PG8_SB(1, 1), cB + hstep + kstep, voffB);
        PG8_WAIT_V(6); PG8_BAR;
    }
    for (;;) {
        const bool has_next = S.next(ui + 1, nxt);
        const char* nA = has_next ? (const char*)g.A + (size_t)nxt.pm * tstep : cA; const char* nB = has_next ? (const char*)g.Bt + (size_t)nxt.pn * tstep : cB;
        for (int t = 0; t < nt; t += 2) {
            const bool last = (t == nt - 2);
            const char* a1 = cA + (size_t)(t + 1) * kstep;
            const char* a2 = last ? nA : cA + (size_t)(t + 2) * kstep; const char* b2 = last ? nB : cB + (size_t)(t + 2) * kstep;
            const char* a3 = a2 + kstep; const char* b3 = b2 + kstep;
            if (last && has_next) S.a_ready(nxt);
            if constexpr (SP2) {
            PG8_LDB(B0, 0, 0); PG8_LDB(B1, 0, 1); PG8_SCHED; PG8_LDA(At, 0, 0); PG8_STAGE(PG8_SA(1, 1), a1 + hstep, voffA);
            PG8_WAIT_V(8); PG8_WAIT_L(0); PG8_BAR; PG8_MMA(0, 0, At, B0); PG8_MMA(0, 1, At, B1); PG8_BAR; PG8_SCHED;
            PG8_LDA(At, 0, 1); PG8_STAGE(PG8_SB(0, 0), b2, voffB); PG8_STAGE(PG8_SB(0, 1), b2 + hstep, voffB); PG8_STAGE(PG8_SA(0, 0), a2, voffA);
            PG8_WAIT_V(8); PG8_WAIT_L(0); PG8_BAR; PG8_MMA(1, 0, At, B0); PG8_MMA(1, 1, At, B1); PG8_BAR; PG8_SCHED;
            PG8_LDB(B0, 1, 0); PG8_LDB(B1, 1, 1); PG8_SCHED; PG8_LDA(At, 1, 0); PG8_STAGE(PG8_SA(0, 1), a2 + hstep, voffA);
            PG8_WAIT_V(8); PG8_WAIT_L(0); PG8_BAR; PG8_MMA(0, 0, At, B0); PG8_MMA(0, 1, At, B1); PG8_BAR; PG8_SCHED;
            PG8_LDA(At, 1, 1); PG8_STAGE(PG8_SB(1, 0), b3, voffB); PG8_STAGE(PG8_SB(1, 1), b3 + hstep, voffB); PG8_STAGE(PG8_SA(1, 0), a3, voffA);
            PG8_WAIT_V(8); PG8_WAIT_L(0); PG8_BAR; PG8_MMA(1, 0, At, B0); PG8_MMA(1, 1, At, B1); PG8_BAR; PG8_SCHED;
            } else {
            PG8_LDB(B0, 0, 0); PG8_SCHED; PG8_LDA(At, 0, 0); PG8_STAGE(PG8_SA(1, 1), a1 + hstep, voffA);
            PG8_WAIT_L(8); PG8_BAR; PG8_WAIT_L(0); PG8_MMA(0, 0, At, B0); PG8_BAR; PG8_SCHED;
            PG8_LDB(B1, 0, 1); PG8_STAGE(PG8_SB(0, 0), b2, voffB);
            PG8_BAR; PG8_WAIT_L(0); PG8_MMA(0, 1, At, B1); PG8_BAR;
            PG8_LDA(At, 0, 1); PG8_STAGE(PG8_SA(0, 0), a2, voffA);
            PG8_BAR; PG8_WAIT_L(0); PG8_MMA(1, 0, At, B0); PG8_BAR; PG8_SCHED;
            PG8_STAGE(PG8_SB(0, 1), b2 + hstep, voffB);
            PG8_WAIT_V(6); PG8_BAR; PG8_MMA(1, 1, At, B1); PG8_BAR;
            PG8_LDB(B0, 1, 0); PG8_SCHED; PG8_LDA(At, 1, 0); PG8_STAGE(PG8_SA(0, 1), a2 + hstep, voffA);
            PG8_WAIT_L(8); PG8_BAR; PG8_WAIT_L(0); PG8_MMA(0, 0, At, B0); PG8_BAR; PG8_SCHED;
            PG8_LDB(B1, 1, 1); PG8_STAGE(PG8_SB(1, 0), b3, voffB);
            PG8_BAR; PG8_WAIT_L(0); PG8_MMA(0, 1, At, B1); PG8_BAR;
            PG8_LDA(At, 1, 1); PG8_STAGE(PG8_SA(1, 0), a3, voffA);
            PG8_BAR; PG8_WAIT_L(0); PG8_MMA(1, 0, At, B0); PG8_BAR; PG8_SCHED;
            PG8_STAGE(PG8_SB(1, 1), b3 + hstep, voffB);
            PG8_WAIT_V(6); PG8_BAR; PG8_MMA(1, 1, At, B1); PG8_BAR;
            }
        }
        if constexpr (ALIGN_EPI) { if (wr == 0) PG8_BAR; }
        if constexpr (!Epi::AFTER_DRAIN) { E(acc, cur, wr, wc, fr, fq); S.done(cur); }
        if (!has_next) break;
#pragma unroll
        for (int a = 0; a < 2; ++a)
#pragma unroll
            for (int b = 0; b < 2; ++b)
#pragma unroll
                for (int m = 0; m < 4; ++m)
#pragma unroll
                    for (int n = 0; n < 2; ++n) acc[a][b][m][n] = (f32x4){0.f, 0.f, 0.f, 0.f};
        cur = nxt; cA = nA; cB = nB; ++ui;
        if constexpr (ALIGN_EPI) { if (wr == 1) PG8_BAR; }
    }
    PG8_WAIT_V(0);
    if constexpr (!ALIGN_EPI) { if (wr == 0) PG8_BAR; }
    PG8_BAR;
    if constexpr (Epi::AFTER_DRAIN) { E.fused(acc, cur, wr, wc, fr, fq, lds, wid, lane); S.done(cur); }
#undef PG8_SA
#undef PG8_SB
#undef PG8_STAGE
#undef PG8_LDA
#undef PG8_LDB
#undef PG8_MMA
#undef PG8_WAIT_V
#undef PG8_WAIT_L
#undef PG8_BAR
#undef PG8_SCHED
}
}
#define GAS __attribute__((address_space(1)))
#define LAS __attribute__((address_space(3)))
typedef unsigned short bf16;
typedef unsigned v4u __attribute__((ext_vector_type(4)));
typedef float f32x4 __attribute__((ext_vector_type(4)));
typedef short bf16x8 __attribute__((ext_vector_type(8)));
typedef GAS unsigned gu32;
typedef GAS unsigned long long gu64;
#define RLX_AGENT __ATOMIC_RELAXED, __HIP_MEMORY_SCOPE_AGENT
#define LDS_WAIT() asm volatile("s_waitcnt lgkmcnt(0)" ::: "memory")
#define VM_WAIT() asm volatile("s_waitcnt vmcnt(0)" ::: "memory")
__device__ __forceinline__ unsigned long long rt() { return __builtin_amdgcn_s_memrealtime(); }
__device__ __forceinline__ unsigned f2bf(float f) { unsigned u = __builtin_bit_cast(unsigned, f); return (u + 0x7fffu + ((u >> 16) & 1u)) >> 16; }
__device__ __forceinline__ unsigned pk2(float lo, float hi) { return f2bf(lo) | (f2bf(hi) << 16); }
#define XB_TMO      128
#define XB_XCNT(j)  (256  + 64 * (j))
#define XB_XSUB(j)  (1280 + 64 * (j))
#define XB_XGEN(j)  (2304 + 64 * (j))
#define XB_TOP      3328
#define XB_TOPGEN   3392
#define XCD_BAR_WORDS 3456
#define XB_SPIN_CAP (1u << 18)

__device__ __forceinline__ unsigned xb_ld(unsigned* p)              { return __hip_atomic_load(p, __ATOMIC_RELAXED, __HIP_MEMORY_SCOPE_AGENT); }
__device__ __forceinline__ unsigned xb_add(unsigned* p, unsigned v) { return __hip_atomic_fetch_add(p, v, __ATOMIC_RELAXED, __HIP_MEMORY_SCOPE_AGENT); }
__device__ __forceinline__ unsigned xb_xcc_id() { return (unsigned)__builtin_amdgcn_s_getreg((3 << 11) | 20) & 0xFu; }
#define XB_SPIN(cond, bar) do { unsigned _sp = 0; while (cond) { __builtin_amdgcn_s_sleep(1); \
    if ((++_sp & 255u) == 0u) { if (xb_ld(&(bar)[XB_TMO])) break; if (_sp > XB_SPIN_CAP) { atomicAdd(&(bar)[XB_TMO], 1u); break; } } } } while (0)

struct XcdBarrier {
    unsigned* bar; unsigned x;
    volatile LAS unsigned* st;
};

__device__ __forceinline__ XcdBarrier xcd_barrier_post(unsigned* bar, volatile LAS unsigned* st) {
    XcdBarrier b; b.bar = bar; b.x = (unsigned)__builtin_amdgcn_readfirstlane((int)xb_xcc_id()); b.st = st;
    if (threadIdx.x == 0) (void)xb_add(&bar[XB_XCNT(b.x)], 1u);
    return b;
}
__device__ __forceinline__ void xcd_barrier_complete(unsigned* bar, unsigned x, unsigned& nloc, unsigned& nx) {
    const unsigned G = gridDim.x * gridDim.y * gridDim.z;
    unsigned sum, cnt, mine, sp = 0u;
    for (;;) {
        sum = 0u; cnt = 0u; mine = 0u;
#pragma unroll
        for (unsigned j = 0; j < 16; ++j) { const unsigned c = xb_ld(&bar[XB_XCNT(j)]); sum += c; cnt += (c > 0u) ? 1u : 0u; mine = (j == x) ? c : mine; }
        if (sum == G) break;
        __builtin_amdgcn_s_sleep(1);
        if ((++sp & 255u) == 0u) { if (xb_ld(&bar[XB_TMO])) break; if (sp > XB_SPIN_CAP) { atomicAdd(&bar[XB_TMO], 1u); break; } }
    }
    nloc = mine > 0u ? mine : 1u; nx = cnt > 0u ? cnt : 1u;
}

__device__ __forceinline__ void xcd_barrier(const XcdBarrier& b) {
    asm volatile("s_waitcnt vmcnt(0)" ::: "memory");
    __syncthreads();
    if (threadIdx.x == 0) {
        unsigned* bar = b.bar;
        __builtin_amdgcn_s_waitcnt(0);
        unsigned nloc = b.st[0], nx = b.st[1];
        if (nloc == 0u) { xcd_barrier_complete(bar, b.x, nloc, nx); b.st[0] = nloc; b.st[1] = nx; }
        const unsigned old = xb_add(&bar[XB_XSUB(b.x)], 1u);
        const unsigned gen = old / nloc;
        if (old + 1u == (gen + 1u) * nloc) {
            __builtin_amdgcn_fence(__ATOMIC_RELEASE, "agent");
            asm volatile("s_waitcnt vmcnt(0)" ::: "memory");
            const unsigned og = xb_add(&bar[XB_TOP], 1u);
            const unsigned tg = og / nx;
            if (og + 1u == (tg + 1u) * nx) xb_add(&bar[XB_TOPGEN], 1u);
            else XB_SPIN(xb_ld(&bar[XB_TOPGEN]) == tg, bar);
            __builtin_amdgcn_fence(__ATOMIC_ACQUIRE, "agent");
            xb_add(&bar[XB_XGEN(b.x)], 1u);
            asm volatile("s_waitcnt vmcnt(0)" ::: "memory");
        } else {
            XB_SPIN(xb_ld(&bar[XB_XGEN(b.x)]) == gen, bar);
            __builtin_amdgcn_fence(__ATOMIC_ACQUIRE, "agent");
            asm volatile("s_waitcnt vmcnt(0)" ::: "memory");
        }
    }
    __syncthreads();
}

constexpr int NWAVES = 8;
constexpr int BATCH = 4, SEQ = 8192, DM = 1024, DEPTH = 2, M = BATCH * SEQ;
constexpr int DPROJ = 3352, NP = 3584;
constexpr int C_POOLV = 0, C_POOLZ = 256, C_CONVB = 512, C_CONVC = 768, C_CONVX = 1024, C_CONVZ = 1280, C_Q = 1536,
              C_KCMP = 2048, C_VCMP = 2176, C_KSLC = 2304, C_VSLC = 2432, C_KWIN = 2560, C_VWIN = 2688, C_NSAZ = 2816, C_GATE = 3328;
constexpr float LN_EPS = 1e-5f, LOG2E = 1.4426950408889634f, QSCALE = 0.125f * LOG2E;
constexpr float ALPHA = 1.4142135623730951f;
constexpr int NCMP_PAD = 512;

constexpr size_t MiB = 1u << 20;
constexpr size_t WS_CTL = 0, CTL_ZERO_BYTES = 1 * MiB;
constexpr size_t WS_WIN = 2 * MiB;
constexpr size_t WS_WOUT = 16 * MiB;
constexpr size_t WS_W1T = 20 * MiB;
constexpr size_t WS_W2T = 22 * MiB;
constexpr size_t WS_PWT = 22 * MiB + 65536;
constexpr size_t WS_TBL = 22 * MiB + 131072;
constexpr size_t WS_XB = 32 * MiB;
constexpr size_t WS_PROJ = 96 * MiB;
constexpr size_t WS_VBUF = 96 * MiB;
constexpr size_t WS_KC = 320 * MiB, WS_VC = 320 * MiB + 524288;
constexpr size_t WS_YMIX = 322 * MiB;
constexpr size_t WS_END = 386 * MiB;
constexpr int CW_BAR = 4096;

constexpr int RING_BYTES = 131072;
constexpr int LDSCTL_OFF = 143360, MISC_OFF = LDSCTL_OFF + 320;
constexpr int LDS_BYTES = 147456;

__device__ __forceinline__ float bf2f(unsigned short h) { return __uint_as_float((unsigned)h << 16); }
__device__ __forceinline__ float ex2(float x) { return __builtin_amdgcn_exp2f(x); }
__device__ __forceinline__ float sigm(float x) { return __builtin_amdgcn_rcpf(1.f + ex2(-x * LOG2E)); }
__device__ __forceinline__ float silu(float x) { return x * sigm(x); }
__device__ __forceinline__ void unpack8(const v4u& w, float (&f)[8]) {
    f[0] = __uint_as_float(w.x << 16); f[1] = __uint_as_float(w.x & 0xffff0000u); f[2] = __uint_as_float(w.y << 16); f[3] = __uint_as_float(w.y & 0xffff0000u);
    f[4] = __uint_as_float(w.z << 16); f[5] = __uint_as_float(w.z & 0xffff0000u); f[6] = __uint_as_float(w.w << 16); f[7] = __uint_as_float(w.w & 0xffff0000u); }
__device__ __forceinline__ v4u pack8(const float (&f)[8]) { v4u o; o.x = pk2(f[0], f[1]); o.y = pk2(f[2], f[3]); o.z = pk2(f[4], f[5]); o.w = pk2(f[6], f[7]); return o; }
__device__ __forceinline__ float wave_sum(float v) {
#pragma unroll
    for (int o = 1; o < 64; o <<= 1) v += __shfl_xor(v, o);
    return v;
}

struct KArgs { const float* in[15]; float* out; unsigned char* ws; };

template <bool WIN>
__device__ __forceinline__ void transpose_item(const float* W, int K, int N, bf16* WT, LAS float* scr, int item, int lane) {
    const int nblk = (N + 31) / 32, kb = item / nblk, nb = item % nblk, k0 = 64 * kb, n0 = 32 * nb;
    { const int n = n0 + (lane & 31); const bool ok = n < N;
      const float sc = (WIN && n >= 1536 && n < 2048) ? QSCALE : 1.f;
#pragma unroll 8
      for (int i = 0; i < 32; ++i) { const int kk = 2 * i + (lane >> 5); scr[kk * 33 + (lane & 31)] = ok ? W[(size_t)(k0 + kk) * N + n] * sc : 0.f; } }
    LDS_WAIT(); asm volatile("" ::: "memory");
    const int c = lane & 7;
#pragma unroll
    for (int j = 0; j < 4; ++j) { const int nl = (lane >> 3) + 8 * j, n = n0 + nl; const LAS float* s = scr + (8 * c) * 33 + nl;
        v4u o; o.x = pk2(s[0 * 33], s[1 * 33]); o.y = pk2(s[2 * 33], s[3 * 33]); o.z = pk2(s[4 * 33], s[5 * 33]); o.w = pk2(s[6 * 33], s[7 * 33]);
        int dr = n; if (WIN) dr = n < 2816 ? n : (n < 2840 ? n + 512 : n - 24);
        if (n < N) *(GAS v4u*)(WT + (size_t)dr * K + k0 + 8 * c) = o; }
    LDS_WAIT(); asm volatile("" ::: "memory");
}
__device__ __forceinline__ void row_to_bf16(const float* xrow, bf16* orow, int lane) {
    const GAS f32x4* xr = (const GAS f32x4*)xrow + lane; GAS unsigned long long* o8 = (GAS unsigned long long*)orow + lane;
#pragma unroll
    for (int j = 0; j < 4; ++j) { const f32x4 v = xr[64 * j]; o8[64 * j] = (unsigned long long)pk2(v.x, v.y) | ((unsigned long long)pk2(v.z, v.w) << 32); }
}
__device__ __forceinline__ int rel_bucket(int d) {
    if (d < 16) return d;
    return 16 + (d >= 19) + (d >= 21) + (d >= 24) + (d >= 27) + (d >= 31) + (d >= 35) + (d >= 40) + (d >= 46) + (d >= 52) + (d >= 59) + (d >= 67) + (d >= 77) + (d >= 87) + (d >= 99) + (d >= 113);
}
__device__ __forceinline__ void prologue(const KArgs& a, LAS unsigned char* lds, int gw, int NGW, int wave, int lane) {
    unsigned char* ws = a.ws;
    LAS float* scr = (LAS float*)(lds + wave * 16384);
    constexpr int I_WIN = 16 * 105, I_WOUT = 16 * 32, I_W1 = 32 * 4, I_W2 = 2 * 2, I_PW = 1 * 2;
    constexpr int N_WIN = 2 * I_WIN, N_WOUT = 2 * I_WOUT, N_W1 = 4 * I_W1, N_W2 = 4 * I_W2, N_PW = 8 * I_PW;
    constexpr int NITEMS = N_WIN + N_WOUT + N_W1 + N_W2 + N_PW;
    for (int it = gw; it < NITEMS; it += NGW) {
        int r = it;
        if (r < N_WIN) { const int l = r / I_WIN; transpose_item<true>(a.in[1] + (size_t)l * DM * DPROJ, DM, DPROJ, (bf16*)(ws + WS_WIN) + (size_t)l * NP * DM, scr, r % I_WIN, lane); continue; } r -= N_WIN;
        if (r < N_WOUT) { const int l = r / I_WOUT; transpose_item<false>(a.in[2] + (size_t)l * DM * DM, DM, DM, (bf16*)(ws + WS_WOUT) + (size_t)l * DM * DM, scr, r % I_WOUT, lane); continue; } r -= N_WOUT;
        if (r < N_W1) { const int idx = r / I_W1, l = idx >> 1; const float* src = (idx & 1) ? a.in[10] : a.in[7];
            transpose_item<false>(src + (size_t)l * 2048 * 128, 2048, 128, (bf16*)(ws + WS_W1T) + (size_t)idx * 128 * 2048, scr, r % I_W1, lane); continue; } r -= N_W1;
        if (r < N_W2) { const int idx = r / I_W2, l = idx >> 1; const float* src = (idx & 1) ? a.in[11] : a.in[8];
            transpose_item<false>(src + (size_t)l * 128 * 64, 128, 64, (bf16*)(ws + WS_W2T) + (size_t)idx * 64 * 128, scr, r % I_W2, lane); continue; } r -= N_W2;
        { const int idx = r / I_PW; transpose_item<false>(a.in[3] + (size_t)idx * 64 * 64, 64, 64, (bf16*)(ws + WS_PWT) + (size_t)idx * 64 * 64, scr, r % I_PW, lane); }
    }
    for (int r = gw; r < 2 * (NP - DPROJ); r += NGW) {
        const int l = r / (NP - DPROJ), row = DPROJ + r % (NP - DPROJ);
        GAS v4u* p = (GAS v4u*)((bf16*)(ws + WS_WIN) + ((size_t)l * NP + row) * DM); const v4u z = {0u, 0u, 0u, 0u}; p[lane] = z; p[lane + 64] = z; }
    for (int m = gw; m < M; m += NGW) row_to_bf16(a.in[0] + (size_t)m * DM, (bf16*)(ws + WS_XB) + (size_t)m * DM, lane);
    if (gw == 0) { float* tbl = (float*)(ws + WS_TBL);
        for (int idx = lane; idx < 8 * 129; idx += 64) { const int h = idx / 129, dd = idx % 129; tbl[h * 132 + dd] = a.in[12][rel_bucket(dd) * 8 + h] * LOG2E; } }
}

__device__ __forceinline__ void poolconv_tile(int tile, int l, const KArgs& a, LAS unsigned char* lds, int tid) {
    const bf16* proj = (const bf16*)(a.ws + WS_PROJ); bf16* ymix = (bf16*)(a.ws + WS_YMIX);
    const bf16* PWT = (const bf16*)(a.ws + WS_PWT); const float* pscale = a.in[4] + l * 256; const float* convw = a.in[5] + l * 768;
    const int lane = tid & 63, wave = __builtin_amdgcn_readfirstlane(tid >> 6);
    const long m0 = (long)tile * 64; const int t0 = (int)(m0 % SEQ);
    LAS unsigned char* VT = lds; LAS unsigned char* PT = lds + 40960; LAS unsigned char* YT = lds + 75776;
    for (int idx = tid; idx < 79 * 32; idx += 512) { const int rr = idx >> 5, ch = idx & 31, t = t0 - 15 + rr; v4u v = {0u, 0u, 0u, 0u};
        if (t >= 0) v = *(const v4u*)(proj + (size_t)(m0 - 15 + rr) * NP + C_POOLV + ch * 8);
        *(LAS v4u*)(VT + rr * 512 + ch * 16) = v; }
    __syncthreads();
#pragma unroll 1
    for (int k = 0; k < 4; ++k) { const int idx = tid + 512 * k, tl = idx >> 5, ch = idx & 31, gi = ch >> 3, w = 2 << gi, t = t0 + tl; const int nwin = w < t + 1 ? w : t + 1;
        float s[8] = {0.f, 0.f, 0.f, 0.f, 0.f, 0.f, 0.f, 0.f}, cur[8];
        { const v4u t_ = *(const LAS v4u*)(VT + (tl + 15) * 512 + ch * 16); unpack8(t_, cur); }
        for (int i = 0; i < nwin; ++i) { float f[8]; { const v4u t_ = *(const LAS v4u*)(VT + (tl + 15 - i) * 512 + ch * 16); unpack8(t_, f); }
#pragma unroll
            for (int e = 0; e < 8; ++e) s[e] += f[e]; }
        const float cntf = (float)nwin; float p[8];
#pragma unroll
        for (int e = 0; e < 8; ++e) p[e] = s[e] / cntf - cur[e];
        *(LAS v4u*)(PT + tl * 528 + ch * 16) = pack8(p); }
    __syncthreads();
    { const int gi = wave & 3, th = wave >> 2, fr = lane & 15, fq = lane >> 4;
      f32x4 acc[2][4];
#pragma unroll
      for (int rt = 0; rt < 2; ++rt)
#pragma unroll
          for (int ct = 0; ct < 4; ++ct) acc[rt][ct] = (f32x4){0.f, 0.f, 0.f, 0.f};
#pragma unroll
      for (int ks = 0; ks < 2; ++ks) { bf16x8 av[2], bv[4];
#pragma unroll
          for (int rt = 0; rt < 2; ++rt) av[rt] = *(const LAS bf16x8*)(PT + (th * 32 + rt * 16 + fr) * 528 + (gi * 64 + ks * 32 + 8 * fq) * 2);
#pragma unroll
          for (int ct = 0; ct < 4; ++ct) bv[ct] = *(const bf16x8*)(PWT + ((size_t)(l * 4 + gi) * 64 + ct * 16 + fr) * 64 + ks * 32 + 8 * fq);
#pragma unroll
          for (int rt = 0; rt < 2; ++rt)
#pragma unroll
              for (int ct = 0; ct < 4; ++ct) acc[rt][ct] = __builtin_amdgcn_mfma_f32_16x16x32_bf16(av[rt], bv[ct], acc[rt][ct], 0, 0, 0); }
#pragma unroll
      for (int rt = 0; rt < 2; ++rt)
#pragma unroll
          for (int ct = 0; ct < 4; ++ct) { const int col = gi * 64 + ct * 16 + fr; const float sc = pscale[col];
#pragma unroll
              for (int rg = 0; rg < 4; ++rg) { const int tl = th * 32 + rt * 16 + 4 * fq + rg; *(LAS float*)(YT + tl * 1040 + col * 4) = acc[rt][ct][rg] * sc; } } }
    __syncthreads();
#pragma unroll 1
    for (int k = 0; k < 4; ++k) { const int idx = tid + 512 * k, tl = idx >> 5, ch = idx & 31, col = ch * 8, t = t0 + tl; const size_t row = (size_t)(m0 + tl);
        const bf16* pr = proj + row * NP + col; const v4u z4 = {0u, 0u, 0u, 0u};
        { float fz[8], o[8]; unpack8(*(const v4u*)(pr + C_POOLZ), fz);
          const f32x4 y0 = *(const LAS f32x4*)(YT + tl * 1040 + col * 4), y1 = *(const LAS f32x4*)(YT + tl * 1040 + col * 4 + 16);
          o[0] = silu(fz[0]) * y0.x; o[1] = silu(fz[1]) * y0.y; o[2] = silu(fz[2]) * y0.z; o[3] = silu(fz[3]) * y0.w;
          o[4] = silu(fz[4]) * y1.x; o[5] = silu(fz[5]) * y1.y; o[6] = silu(fz[6]) * y1.z; o[7] = silu(fz[7]) * y1.w;
          *(v4u*)(ymix + row * DM + col) = pack8(o); }
        float fb[8], fz[8], c0[8], x0[8], c1[8], x1[8], c2[8], x2[8];
        unpack8(*(const v4u*)(pr + C_CONVB), fb); unpack8(*(const v4u*)(pr + C_CONVZ), fz);
        unpack8(*(const v4u*)(pr + C_CONVC), c0); unpack8(*(const v4u*)(pr + C_CONVX), x0);
        unpack8(t >= 1 ? *(const v4u*)(pr - NP + C_CONVC) : z4, c1); unpack8(t >= 1 ? *(const v4u*)(pr - NP + C_CONVX) : z4, x1);
        unpack8(t >= 2 ? *(const v4u*)(pr - 2 * NP + C_CONVC) : z4, c2); unpack8(t >= 2 ? *(const v4u*)(pr - 2 * NP + C_CONVX) : z4, x2);
        float o[8];
#pragma unroll
        for (int e = 0; e < 8; ++e) { const float y = convw[col + e] * (c2[e] * x2[e]) + convw[256 + col + e] * (c1[e] * x1[e]) + convw[512 + col + e] * (c0[e] * x0[e]);
            o[e] = fb[e] * y * silu(fz[e]); }
        *(v4u*)(ymix + row * DM + 256 + col) = pack8(o); }
    __syncthreads();
}

__device__ __forceinline__ void compress_task(int task, int l, const KArgs& a, LAS unsigned char* lds, int tid) {
    const bf16* proj = (const bf16*)(a.ws + WS_PROJ);
    const int lane = tid & 63, wave = __builtin_amdgcn_readfirstlane(tid >> 6);
    const int kv = task & 1, bg = (task >> 1) & 7, nt = task >> 4, b = bg >> 1, g = bg & 1;
    const float* pe = (kv ? a.in[9] : a.in[6]) + l * 32 * 64;
    const bf16* w1 = (const bf16*)(a.ws + WS_W1T) + (size_t)(l * 2 + kv) * 128 * 2048; const bf16* w2 = (const bf16*)(a.ws + WS_W2T) + (size_t)(l * 2 + kv) * 64 * 128;
    const int ccol = (kv ? C_VCMP : C_KCMP) + g * 64, fr = lane & 15, fq = lane >> 4, n = nt * 16 + fr;
    f32x4 acc[8];
#pragma unroll
    for (int ct = 0; ct < 8; ++ct) acc[ct] = (f32x4){0.f, 0.f, 0.f, 0.f};
#pragma unroll
    for (int i = 0; i < 8; ++i) { const int ks = 8 * wave + i, lpos = ks >> 1, d = (ks & 1) * 32 + 8 * fq; int trow = 16 * n + lpos; trow = trow < SEQ ? trow : SEQ - 1;
        float f[8]; unpack8(*(const v4u*)(proj + ((size_t)b * SEQ + trow) * NP + ccol + d), f);
        const f32x4 pe0 = *(const f32x4*)(pe + lpos * 64 + d), pe1 = *(const f32x4*)(pe + lpos * 64 + d + 4);
        f[0] += pe0.x; f[1] += pe0.y; f[2] += pe0.z; f[3] += pe0.w; f[4] += pe1.x; f[5] += pe1.y; f[6] += pe1.z; f[7] += pe1.w;
        const bf16x8 av = __builtin_bit_cast(bf16x8, pack8(f));
#pragma unroll
        for (int ct = 0; ct < 8; ++ct) { const bf16x8 bv = *(const bf16x8*)(w1 + (size_t)(ct * 16 + fr) * 2048 + ks * 32 + 8 * fq); acc[ct] = __builtin_amdgcn_mfma_f32_16x16x32_bf16(av, bv, acc[ct], 0, 0, 0); } }
#pragma unroll
    for (int ct = 0; ct < 8; ++ct) *(LAS f32x4*)(lds + wave * 8192 + (ct * 64 + lane) * 16) = acc[ct];
    __syncthreads();
    { f32x4 sum = (f32x4){0.f, 0.f, 0.f, 0.f};
#pragma unroll
      for (int pw = 0; pw < 8; ++pw) sum += *(const LAS f32x4*)(lds + pw * 8192 + (wave * 64 + lane) * 16);
#pragma unroll
      for (int rg = 0; rg < 4; ++rg) *(LAS unsigned short*)(lds + 65536 + (4 * fq + rg) * 272 + (wave * 16 + fr) * 2) = (unsigned short)f2bf(silu(sum[rg])); }
    __syncthreads();
    if (wave < 4) { f32x4 acc2 = (f32x4){0.f, 0.f, 0.f, 0.f};
#pragma unroll
        for (int ks = 0; ks < 4; ++ks) { const bf16x8 av = *(const LAS bf16x8*)(lds + 65536 + fr * 272 + (ks * 32 + 8 * fq) * 2);
            const bf16x8 bv = *(const bf16x8*)(w2 + (size_t)(wave * 16 + fr) * 128 + ks * 32 + 8 * fq); acc2 = __builtin_amdgcn_mfma_f32_16x16x32_bf16(av, bv, acc2, 0, 0, 0); }
        bf16* dst = (bf16*)(a.ws + (kv ? WS_VC : WS_KC)) + ((size_t)(b * 2 + g) * NCMP_PAD + nt * 16) * 64;
#pragma unroll
        for (int rg = 0; rg < 4; ++rg) dst[(4 * fq + rg) * 64 + wave * 16 + fr] = (bf16)f2bf(acc2[rg]); }
    __syncthreads();
}

__device__ __forceinline__ void ln_row(const float* vrow, const float* gam, const float* bet, float* orow, bf16* xbrow, int lane) {
    const GAS f32x4* xr = (const GAS f32x4*)vrow + lane;
    f32x4 v[4]; float s = 0.f;
#pragma unroll
    for (int j = 0; j < 4; ++j) { v[j] = xr[64 * j]; s += (v[j].x + v[j].y) + (v[j].z + v[j].w); }
    const float mean = wave_sum(s) * (1.f / DM); float s2 = 0.f;
#pragma unroll
    for (int j = 0; j < 4; ++j) { v[j] = v[j] - mean; s2 += (v[j].x * v[j].x + v[j].y * v[j].y) + (v[j].z * v[j].z + v[j].w * v[j].w); }
    const float rstd = 1.f / sqrtf(wave_sum(s2) * (1.f / DM) + LN_EPS);
#pragma unroll
    for (int j = 0; j < 4; ++j) { const f32x4 gg = ((const f32x4*)gam)[lane + 64 * j], bb = ((const f32x4*)bet)[lane + 64 * j]; const f32x4 o = v[j] * rstd * gg + bb;
        ((GAS f32x4*)orow)[lane + 64 * j] = o;
        if (xbrow) ((GAS unsigned long long*)xbrow)[lane + 64 * j] = (unsigned long long)pk2(o.x, o.y) | ((unsigned long long)pk2(o.z, o.w) << 32); }
}

namespace nsa {
typedef __attribute__((address_space(3))) unsigned char lds_t;
typedef __attribute__((address_space(3))) float lds_f;
typedef __attribute__((address_space(3))) unsigned lds_u;
using bf16x8 = __attribute__((ext_vector_type(8))) short;
using s16x4 = __attribute__((ext_vector_type(4))) short;
using f32x16 = __attribute__((ext_vector_type(16))) float;
using u32x4 = __attribute__((ext_vector_type(4))) unsigned;
using f32x4 = __attribute__((ext_vector_type(4))) float;
typedef short v4i16_t __attribute__((ext_vector_type(4)));
constexpr int L_K = 0, L_V = 16384, L_IMP = 32768, L_SEL = 65536, L_WS = 66560, L_TBL = 68608, L_END = 70720, L_OST = 73728;
constexpr float NEG2 = -2e30f, MINIT = -1e30f;
constexpr int NSEL_FREE = 13;

__device__ __forceinline__ int crow(int r, int hi) { return (r & 3) + 8 * (r >> 2) + 4 * hi; }
__device__ __forceinline__ unsigned cvtpk(float lo, float hi) { typedef float f2_t __attribute__((ext_vector_type(2))); typedef __bf16 b2_t __attribute__((ext_vector_type(2)));
    f2_t v = {lo, hi}; b2_t b = __builtin_convertvector(v, b2_t); return __builtin_bit_cast(unsigned, b); }
__device__ __forceinline__ float halfmax(float v) { auto rr = __builtin_amdgcn_permlane32_swap(__float_as_uint(v), __float_as_uint(v), false, false); return fmaxf(__uint_as_float(rr[0]), __uint_as_float(rr[1])); }
__device__ __forceinline__ float halfsum(float v) { auto rr = __builtin_amdgcn_permlane32_swap(__float_as_uint(v), __float_as_uint(v), false, false); return __uint_as_float(rr[0]) + __uint_as_float(rr[1]); }
__device__ __forceinline__ s16x4 vtr(const lds_t* p) { return __builtin_bit_cast(s16x4, __builtin_amdgcn_ds_read_tr16_b64_v4i16((__attribute__((address_space(3))) v4i16_t*)p)); }

__device__ __forceinline__ void qkt(f32x16& p0, f32x16& p1, const lds_t* kslot, const bf16x8 (&qr)[4], int c, int hi) {
    const lds_t* kb = kslot + hi * 1024 + c * 16;
#pragma unroll
    for (int r = 0; r < 16; ++r) { p0[r] = 0.f; p1[r] = 0.f; }
#pragma unroll
    for (int d0 = 0; d0 < 4; ++d0) {
        const bf16x8 b0 = *(const __attribute__((address_space(3))) bf16x8*)(kb + d0 * 2048);
        const bf16x8 b1 = *(const __attribute__((address_space(3))) bf16x8*)(kb + d0 * 2048 + 512);
        p0 = __builtin_amdgcn_mfma_f32_32x32x16_bf16(b0, qr[d0], p0, 0, 0, 0);
        p1 = __builtin_amdgcn_mfma_f32_32x32x16_bf16(b1, qr[d0], p1, 0, 0, 0); }
}
__device__ __forceinline__ void pv(f32x16 (&o)[2], const lds_t* vp, const f32x16& p0, const f32x16& p1) {
    u32x4 pw[4];
#pragma unroll
    for (int i = 0; i < 4; ++i) { pw[0][i] = cvtpk(p0[2 * i], p0[2 * i + 1]); pw[1][i] = cvtpk(p0[8 + 2 * i], p0[9 + 2 * i]); pw[2][i] = cvtpk(p1[2 * i], p1[2 * i + 1]); pw[3][i] = cvtpk(p1[8 + 2 * i], p1[9 + 2 * i]); }
#pragma unroll
    for (int d0 = 0; d0 < 2; ++d0)
#pragma unroll
        for (int ks = 0; ks < 4; ++ks) {
            const s16x4 lo = vtr(vp + d0 * 4096 + ks * 1024), hh = vtr(vp + d0 * 4096 + ks * 1024 + 512);
            const bf16x8 vf = {lo[0], lo[1], lo[2], lo[3], hh[0], hh[1], hh[2], hh[3]};
            o[d0] = __builtin_amdgcn_mfma_f32_32x32x16_bf16(__builtin_bit_cast(bf16x8, pw[ks]), vf, o[d0], 0, 0, 0); }
}
template <int MODE, bool GEN>
__device__ __forceinline__ void score_xform(f32x16& p0, f32x16& p1, int tile, int tq, bool sel, float cfar, const lds_f* tblh, int hi) {
    if (!GEN) {
#pragma unroll
        for (int r = 0; r < 16; ++r) { p0[r] = (MODE != 2 || sel) ? p0[r] + cfar : NEG2; p1[r] = (MODE != 2 || sel) ? p1[r] + cfar : NEG2; }
    } else {
        const int db = (MODE == 1) ? tq - 1024 * tile - 31 : tq - 64 * tile;
        constexpr int KS = (MODE == 1) ? 16 : 1;
#pragma unroll
        for (int r = 0; r < 16; ++r) { const int d0 = db - KS * crow(r, hi), d1 = d0 - 32 * KS;
            const int i0 = d0 < 0 ? 0 : (d0 > 128 ? 128 : d0), i1 = d1 < 0 ? 0 : (d1 > 128 ? 128 : d1);
            const float b0 = tblh[i0], b1 = tblh[i1];
            const bool v0 = d0 >= 0 && (MODE == 1 || (MODE == 2 ? sel : d0 < 512)), v1 = d1 >= 0 && (MODE == 1 || (MODE == 2 ? sel : d1 < 512));
            p0[r] = v0 ? p0[r] + b0 : NEG2; p1[r] = v1 ? p1[r] + b1 : NEG2; }
    }
}
template <bool WITH_O>
__device__ __forceinline__ void softmax_step(f32x16& p0, f32x16& p1, float& m, float& l, f32x16 (&o)[2], lds_f* wsf, int c, int hi) {
    float tm = fmaxf(p0[0], p1[0]);
#pragma unroll
    for (int r = 1; r < 16; ++r) tm = fmaxf(tm, fmaxf(p0[r], p1[r]));
    tm = halfmax(tm);
    if (__any(tm > m)) {
        const float mn = fmaxf(m, tm), alpha = ex2(m - mn); m = mn; l *= alpha;
        if (WITH_O) {
            if (hi == 0) wsf[c] = alpha;
            asm volatile("" ::: "memory");
#pragma unroll
            for (int r = 0; r < 16; ++r) { const float al = wsf[crow(r, hi)]; o[0][r] *= al; o[1][r] *= al; }
            asm volatile("" ::: "memory");
        }
    }
    float s = 0.f;
#pragma unroll
    for (int r = 0; r < 16; ++r) { p0[r] = ex2(p0[r] - m); p1[r] = ex2(p1[r] - m); s += p0[r] + p1[r]; }
    l += s;
}
template <bool FIRST>
__device__ __forceinline__ void accum_scaled(lds_f* ost, const f32x16 (&o)[2], float coef, lds_f* wsf, int c, int hi) {
    if (hi == 0) wsf[32 + c] = coef;
    asm volatile("" ::: "memory");
#pragma unroll
    for (int r = 0; r < 16; ++r) { const int orow = crow(r, hi); const float al = wsf[32 + orow];
        if (FIRST) { ost[orow * 64 + c] = al * o[0][r]; ost[orow * 64 + 32 + c] = al * o[1][r]; }
        else { ost[orow * 64 + c] += al * o[0][r]; ost[orow * 64 + 32 + c] += al * o[1][r]; } }
    asm volatile("" ::: "memory");
}

template <int MODE, bool GEN, int KIND>
__device__ __forceinline__ void run_tiles(int jb, int je, const unsigned short* ksrc, const unsigned short* vsrc, size_t stride, lds_t* lds, unsigned kst, unsigned vst, const lds_t* vlane,
                                          const bf16x8 (&qr)[4], float& m, float& l, f32x16 (&o)[2], int tq, unsigned long long sel_lo, unsigned long long sel_hi, float cfar, const lds_f* tblh,
                                          lds_f* wsf, lds_f* iq, float inv1, bool do_imp, int c, int hi, int hh) {
    if (jb >= je) return;
    constexpr bool HASV = KIND != 1;
    typedef __attribute__((address_space(3))) u32x4 lds_u4;
    u32x4 kreg, vreg = {0u, 0u, 0u, 0u};
    kreg = *(const u32x4*)(ksrc + (size_t)jb * stride); if (HASV) vreg = *(const u32x4*)(vsrc + (size_t)jb * stride);
    *(lds_u4*)(lds + L_K + (jb & 1) * 8192 + kst) = kreg; if (HASV) *(lds_u4*)(lds + L_V + (jb & 1) * 8192 + vst) = vreg;
    __syncthreads();
#pragma unroll 1
    for (int j = jb; j < je; ++j) {
        if (j + 1 < je) { kreg = *(const u32x4*)(ksrc + (size_t)(j + 1) * stride); if (HASV) vreg = *(const u32x4*)(vsrc + (size_t)(j + 1) * stride); }
        bool sel = true;
        if (MODE == 2) sel = (((j < 64 ? sel_lo : sel_hi) >> (j & 63)) & 1ull) != 0ull;
        if (MODE != 2 || __any(sel)) {
            f32x16 p0, p1;
            qkt(p0, p1, lds + L_K + (j & 1) * 8192, qr, c, hi);
            score_xform<MODE, GEN>(p0, p1, j, tq, sel, cfar, tblh, hi);
            if (KIND == 0) { softmax_step<true>(p0, p1, m, l, o, wsf, c, hi); pv(o, vlane + (j & 1) * 8192, p0, p1); }
            else if (KIND == 1) { softmax_step<false>(p0, p1, m, l, o, wsf, c, hi); }
            else {
#pragma unroll
                for (int r = 0; r < 16; ++r) { p0[r] = ex2(p0[r] - m) * inv1; p1[r] = ex2(p1[r] - m) * inv1; }
                if (do_imp) {
#pragma unroll
                    for (int q4 = 0; q4 < 4; ++q4) {
                        float a0 = 2.f * (p0[4 * q4] + p0[4 * q4 + 1] + p0[4 * q4 + 2]) + p0[4 * q4 + 3], b0 = p0[4 * q4 + 3];
                        float a1 = 2.f * (p1[4 * q4] + p1[4 * q4 + 1] + p1[4 * q4 + 2]) + p1[4 * q4 + 3], b1 = p1[4 * q4 + 3];
                        a0 += __shfl_xor(a0, 1); a0 += __shfl_xor(a0, 2); b0 += __shfl_xor(b0, 1); b0 += __shfl_xor(b0, 2);
                        a1 += __shfl_xor(a1, 1); a1 += __shfl_xor(a1, 2); b1 += __shfl_xor(b1, 1); b1 += __shfl_xor(b1, 2);
                        if (hh == 0) { const int j0 = 16 * j + 2 * q4 + hi, j1 = j0 + 8;
                            __hip_atomic_fetch_add(iq + j0, a0, __ATOMIC_RELAXED, __HIP_MEMORY_SCOPE_WORKGROUP); __hip_atomic_fetch_add(iq + j0 + 1, b0, __ATOMIC_RELAXED, __HIP_MEMORY_SCOPE_WORKGROUP);
                            __hip_atomic_fetch_add(iq + j1, a1, __ATOMIC_RELAXED, __HIP_MEMORY_SCOPE_WORKGROUP); if (j1 + 1 < 128) __hip_atomic_fetch_add(iq + j1 + 1, b1, __ATOMIC_RELAXED, __HIP_MEMORY_SCOPE_WORKGROUP); }
                    }
                }
                pv(o, vlane + (j & 1) * 8192, p0, p1);
            }
        }
        if (j + 1 < je) { *(lds_u4*)(lds + L_K + ((j + 1) & 1) * 8192 + kst) = kreg; if (HASV) *(lds_u4*)(lds + L_V + ((j + 1) & 1) * 8192 + vst) = vreg; }
        __syncthreads();
    }
}

__device__ __forceinline__ void nsa_unit(int b, int g, int jq, const KArgs& a, lds_t* lds, int tid) {
    const unsigned short* proj = (const unsigned short*)(a.ws + WS_PROJ);
    const float* tblG = (const float*)(a.ws + WS_TBL);
    const int lane = tid & 63, c = lane & 31, hi = lane >> 5;
    const int wid = __builtin_amdgcn_readfirstlane(tid >> 6);
    const int ql = c >> 2, hh = c & 3, head = 4 * g + hh;
    const int t0 = jq * 64, tw0 = t0 + 8 * wid, tq = tw0 + ql;
    const size_t rowbase = (size_t)b * SEQ;
    const int skey = tid >> 3, sch = tid & 7;
    const unsigned kst = sch * 1024 + skey * 16, vst = (sch >> 2) * 4096 + (skey >> 4) * 1024 + (skey & 15) * 64 + (sch & 3) * 16;
    lds_f* wsf = (lds_f*)(lds + L_WS) + wid * 64;
    lds_f* tbl = (lds_f*)(lds + L_TBL); const lds_f* tblh = tbl + hh * 132;
    lds_f* imp = (lds_f*)(lds + L_IMP); lds_u* selm = (lds_u*)(lds + L_SEL);
    lds_f* ost = (lds_f*)(lds + L_OST) + wid * 2048;
    const lds_t* vlane = lds + L_V + ((lane >> 4) & 1) * 32 + (lane & 3) * 8 + (4 * hi + ((lane & 15) >> 2)) * 64;

    for (int i = tid; i < 64 * 128 / 4; i += 512) ((__attribute__((address_space(3))) f32x4*)imp)[i] = (f32x4){0.f, 0.f, 0.f, 0.f};
    for (int i = tid; i < 4 * 132; i += 512) tbl[i] = tblG[g * 4 * 132 + i];
    bf16x8 qr[4];
    { const unsigned short* qb = proj + (rowbase + tq) * NP + C_Q + head * 64 + hi * 8;
#pragma unroll
      for (int d0 = 0; d0 < 4; ++d0) qr[d0] = *(const bf16x8*)(qb + d0 * 16); }
    const float cfar = tblG[head * 132 + 128];
    f32x16 o[2];
#define NSA_ZERO_O() do { _Pragma("unroll") for (int r_ = 0; r_ < 16; ++r_) { o[0][r_] = 0.f; o[1][r_] = 0.f; } } while (0)

    {
        const unsigned short* KC = (const unsigned short*)(a.ws + WS_KC) + (size_t)(b * 2 + g) * NCMP_PAD * 64 + tid * 8;
        const unsigned short* VC = (const unsigned short*)(a.ws + WS_VC) + (size_t)(b * 2 + g) * NCMP_PAD * 64 + tid * 8;
        int nt1 = (4 * jq + 3 + 63) >> 6; nt1 = nt1 < 8 ? nt1 : 8;
        int nfar = t0 >= 1167 ? ((t0 - 1167) >> 10) + 1 : 0; nfar = nfar < nt1 ? nfar : nt1;
        float m1 = MINIT, l1 = 0.f;
        run_tiles<1, false, 1>(0, nfar, KC, VC, 4096, lds, kst, vst, vlane, qr, m1, l1, o, tq, 0ull, 0ull, cfar, tblh, wsf, nullptr, 0.f, false, c, hi, hh);
        run_tiles<1, true, 1>(nfar, nt1, KC, VC, 4096, lds, kst, vst, vlane, qr, m1, l1, o, tq, 0ull, 0ull, cfar, tblh, wsf, nullptr, 0.f, false, c, hi, hh);
        l1 = halfsum(l1);
        const float inv1 = l1 > 0.f ? 1.f / l1 : 0.f;
        lds_f* iq = imp + (8 * wid + ql) * 128;
        NSA_ZERO_O();
        run_tiles<1, false, 2>(0, nfar, KC, VC, 4096, lds, kst, vst, vlane, qr, m1, l1, o, tq, 0ull, 0ull, cfar, tblh, wsf, iq, inv1, jq >= 16, c, hi, hh);
        run_tiles<1, true, 2>(nfar, nt1, KC, VC, 4096, lds, kst, vst, vlane, qr, m1, l1, o, tq, 0ull, 0ull, cfar, tblh, wsf, iq, inv1, jq >= 16, c, hi, hh);
        const float gate1 = sigm(bf2f(proj[(rowbase + tq) * NP + C_GATE + head * 3 + 0]));
        accum_scaled<true>(ost, o, gate1, wsf, c, hi);
    }
    if (jq >= 16) {
#pragma unroll 1
        for (int qi = 0; qi < 8; ++qi) {
            const lds_f* iqq = imp + (8 * wid + qi) * 128;
            const int j0 = lane, j1 = lane + 64;
            const bool c0 = j0 >= 1 && j0 <= jq - 2, c1 = j1 <= jq - 2;
            const unsigned k0 = c0 ? __float_as_uint(iqq[j0]) + 1u : 0u, k1 = c1 ? __float_as_uint(iqq[j1]) + 1u : 0u;
            unsigned prefix = 0u;
#pragma unroll 1
            for (int bit = 30; bit >= 0; --bit) { const unsigned cand = prefix | (1u << bit);
                const int cnt = __popcll(__ballot(k0 >= cand)) + __popcll(__ballot(k1 >= cand));
                if (cnt >= NSEL_FREE) prefix = cand; }
            const unsigned long long gt0 = __ballot(k0 > prefix), gt1 = __ballot(k1 > prefix), eq0 = __ballot(k0 == prefix), eq1 = __ballot(k1 == prefix);
            const int need = NSEL_FREE - (__popcll(gt0) + __popcll(gt1));
            const unsigned long long lt = (1ull << lane) - 1ull;
            const bool s0 = (k0 > prefix) || (k0 == prefix && __popcll(eq0 & lt) < need);
            const bool s1 = (k1 > prefix) || (k1 == prefix && (__popcll(eq0) + __popcll(eq1 & lt)) < need);
            unsigned long long b0 = __ballot(s0), b1 = __ballot(s1);
            b0 |= 1ull;
            if (jq < 64) b0 |= 1ull << jq; else b1 |= 1ull << (jq - 64);
            if (jq - 1 < 64) b0 |= 1ull << (jq - 1); else b1 |= 1ull << (jq - 65);
            if (lane == 0) { lds_u* sp = selm + (8 * wid + qi) * 4; sp[0] = (unsigned)b0; sp[1] = (unsigned)(b0 >> 32); sp[2] = (unsigned)b1; sp[3] = (unsigned)(b1 >> 32); }
        }
    } else {
        if (lane < 8) { lds_u* sp = selm + (8 * wid + lane) * 4; sp[0] = (2u << jq) - 1u; sp[1] = 0u; sp[2] = 0u; sp[3] = 0u; }
    }
    asm volatile("" ::: "memory");
    unsigned long long sel_lo, sel_hi;
    { const lds_u* sp = selm + (8 * wid + ql) * 4; sel_lo = (unsigned long long)sp[0] | ((unsigned long long)sp[1] << 32); sel_hi = (unsigned long long)sp[2] | ((unsigned long long)sp[3] << 32); }

    const int jn = jq >= 2 ? jq - 2 : 0;
    {
        float m2 = MINIT, l2 = 0.f; NSA_ZERO_O();
        const unsigned short* ks = proj + (rowbase + skey) * NP + C_KSLC + g * 64 + sch * 8; const unsigned short* vs = proj + (rowbase + skey) * NP + C_VSLC + g * 64 + sch * 8;
        run_tiles<2, false, 0>(0, jn, ks, vs, (size_t)64 * NP, lds, kst, vst, vlane, qr, m2, l2, o, tq, sel_lo, sel_hi, cfar, tblh, wsf, nullptr, 0.f, false, c, hi, hh);
        run_tiles<2, true, 0>(jn, jq + 1, ks, vs, (size_t)64 * NP, lds, kst, vst, vlane, qr, m2, l2, o, tq, sel_lo, sel_hi, cfar, tblh, wsf, nullptr, 0.f, false, c, hi, hh);
        l2 = halfsum(l2);
        const float gate2 = sigm(bf2f(proj[(rowbase + tq) * NP + C_GATE + head * 3 + 1]));
        accum_scaled<false>(ost, o, l2 > 0.f ? gate2 / l2 : 0.f, wsf, c, hi);
    }
    {
        float m3 = MINIT, l3 = 0.f; NSA_ZERO_O();
        const unsigned short* ks = proj + (rowbase + skey) * NP + C_KWIN + g * 64 + sch * 8; const unsigned short* vs = proj + (rowbase + skey) * NP + C_VWIN + g * 64 + sch * 8;
        const int jf = jq >= 7 ? jq - 7 : 0;
        if (jq >= 8) run_tiles<3, true, 0>(jq - 8, jq - 7, ks, vs, (size_t)64 * NP, lds, kst, vst, vlane, qr, m3, l3, o, tq, 0ull, 0ull, cfar, tblh, wsf, nullptr, 0.f, false, c, hi, hh);
        run_tiles<3, false, 0>(jf, jn, ks, vs, (size_t)64 * NP, lds, kst, vst, vlane, qr, m3, l3, o, tq, 0ull, 0ull, cfar, tblh, wsf, nullptr, 0.f, false, c, hi, hh);
        run_tiles<3, true, 0>(jn, jq + 1, ks, vs, (size_t)64 * NP, lds, kst, vst, vlane, qr, m3, l3, o, tq, 0ull, 0ull, cfar, tblh, wsf, nullptr, 0.f, false, c, hi, hh);
        l3 = halfsum(l3);
        const float gate3 = sigm(bf2f(proj[(rowbase + tq) * NP + C_GATE + head * 3 + 2]));
        accum_scaled<false>(ost, o, l3 > 0.f ? gate3 / l3 : 0.f, wsf, c, hi);
    }
    {
        unsigned short* ymix = (unsigned short*)(a.ws + WS_YMIX);
        asm volatile("s_waitcnt lgkmcnt(0)" ::: "memory");
#pragma unroll
        for (int i = 0; i < 8; ++i) { const int row = i * 4 + (lane >> 4), ch = lane & 15;
            const f32x4 v = *(const __attribute__((address_space(3))) f32x4*)(ost + row * 64 + ch * 4);
            const size_t tok = rowbase + tw0 + (row >> 2); const int hd = 4 * g + (row & 3);
            const uint2 z = *(const uint2*)(proj + tok * NP + C_NSAZ + hd * 64 + ch * 4);
            const float z0 = __uint_as_float(z.x << 16), z1 = __uint_as_float(z.x & 0xffff0000u), z2 = __uint_as_float(z.y << 16), z3 = __uint_as_float(z.y & 0xffff0000u);
            uint2 w; w.x = pk2(v.x * silu(z0), v.y * silu(z1)); w.y = pk2(v.z * silu(z2), v.w * silu(z3));
            *(uint2*)(ymix + tok * DM + 512 + hd * 64 + ch * 4) = w; }
        __syncthreads();
    }
#undef NSA_ZERO_O
}
}

#ifndef REP_A
#define REP_A 1
#endif
#ifndef REP_B
#define REP_B 1
#endif
#ifndef REP_C
#define REP_C 1
#endif
#ifndef REP_D
#define REP_D 1
#endif
#ifndef REP_E
#define REP_E 1
#endif
__device__ __forceinline__ int opaque_v(int x) { asm volatile("" : "+v"(x)); return x; }
__device__ __forceinline__ int opaque_s(int x) { asm volatile("" : "+s"(x)); return x; }
struct Ids { int tid, lane, wave, G, bx, vcu, gw, NGW; };
__device__ __forceinline__ const KArgs& kargs() { auto p = __builtin_amdgcn_kernarg_segment_ptr(); asm volatile("" : "+s"(p)); return *(const KArgs*)p; }
__device__ __forceinline__ Ids make_ids() {
    Ids d; d.tid = opaque_v((int)threadIdx.x); d.lane = d.tid & 63; d.wave = __builtin_amdgcn_readfirstlane(d.tid >> 6);
    d.G = opaque_s((int)gridDim.x); d.bx = opaque_s((int)blockIdx.x); d.vcu = (d.G % 8 == 0) ? (d.bx % 8) * (d.G / 8) + d.bx / 8 : d.bx;
    d.gw = d.vcu * NWAVES + d.wave; d.NGW = d.G * NWAVES; return d;
}
__global__ void __launch_bounds__(NWAVES * 64, 2) fwd_kernel(KArgs a_unused) {
    extern __shared__ __attribute__((aligned(16))) unsigned char lds_raw[];
    LAS unsigned char* lds = (LAS unsigned char*)lds_raw;
    volatile LAS unsigned* MISC = (volatile LAS unsigned*)(lds + MISC_OFF);
    for (int u = threadIdx.x; u < (LDS_BYTES - LDSCTL_OFF) / 4; u += NWAVES * 64) ((LAS unsigned*)(lds + LDSCTL_OFF))[u] = 0u;
    __syncthreads();
    XcdBarrier bar = xcd_barrier_post((unsigned*)(kargs().ws + WS_CTL) + CW_BAR, MISC + 8);

#pragma unroll 1
    for (int ph = 0; ph < 1 + 5 * DEPTH; ++ph) {
        const int phq = opaque_s(ph); const int l = phq >= 1 ? (phq - 1) / 5 : 0, kph = phq >= 1 ? (phq - 1) % 5 : -1;
        if (kph < 0) { const Ids d = make_ids(); const KArgs& a = kargs(); prologue(a, lds, d.gw, d.NGW, d.wave, d.lane); }
        if (kph == 0) {
#ifndef SKIP_A
        for (int rep_ = 0; rep_ < REP_A; ++rep_) { const Ids d = make_ids(); const KArgs& a = kargs(); unsigned char* ws = a.ws;
          pg8::Gemm g{(const pg8::bf16_t*)(ws + WS_XB), (const pg8::bf16_t*)(ws + WS_WIN) + (size_t)l * NP * DM, M, NP, DM}; pg8::StaticOrder S; S.init(M, NP, d.G, d.bx);
          pg8::EpiBf16 E{(pg8::bf16_t*)(ws + WS_PROJ), NP};
          pg8::gemm_phase<pg8::EpiBf16, pg8::StaticOrder, true, true>(lds, g, S, E); }
#endif
        }
        if (kph == 1) {
        for (int rep_ = 0; rep_ < REP_B; ++rep_) { const Ids d = make_ids(); const KArgs& a = kargs();
#ifndef SKIP_B1
#pragma unroll 1
          for (int tile = d.vcu; tile < M / 64; tile += d.G) poolconv_tile(tile, l, a, lds, d.tid);
#endif
#ifndef SKIP_B2
#pragma unroll 1
          for (int task = d.vcu; task < 512; task += d.G) compress_task(task, l, a, lds, d.tid);
#endif
          if (REP_B > 1) __syncthreads();
        }
        }
        if (kph == 2) {
#ifndef SKIP_C
        for (int rep_ = 0; rep_ < REP_C; ++rep_) { const Ids d = make_ids(); const KArgs& a = kargs(); const int nun = (d.G == 256) ? 4 : (1024 - d.vcu + d.G - 1) / d.G;
#pragma unroll 1
          for (int i = 0; i < nun; ++i) { int bg, jq;
              if (d.G == 256) { const int s = d.vcu & 31; bg = d.vcu >> 5; jq = (i == 0) ? 127 - s : (i == 1) ? 64 + s : (i == 2) ? 63 - s : s; }
              else { const int u = d.vcu + i * d.G; bg = u >> 7; jq = u & 127; }
              nsa::nsa_unit(bg >> 1, bg & 1, jq, a, (nsa::lds_t*)lds, d.tid); } }
#endif
        }
        if (kph == 3) {
#ifndef SKIP_D
        for (int rep_ = 0; rep_ < REP_D; ++rep_) { const Ids d = make_ids(); const KArgs& a = kargs(); unsigned char* ws = a.ws;
          pg8::Gemm g{(const pg8::bf16_t*)(ws + WS_YMIX), (const pg8::bf16_t*)(ws + WS_WOUT) + (size_t)l * DM * DM, M, DM, DM}; pg8::StaticOrder S; S.init(M, DM, d.G, d.bx);
          pg8::EpiResid E{l == 0 ? a.in[0] : a.out, (float*)(ws + WS_VBUF), DM, ALPHA};
          pg8::gemm_phase<pg8::EpiResid, pg8::StaticOrder, true, true>(lds, g, S, E); }
#endif
        }
        if (kph == 4) {
        for (int rep_ = 0; rep_ < REP_E; ++rep_) { const Ids d = make_ids(); const KArgs& a = kargs(); unsigned char* ws = a.ws; const float* gam = a.in[13] + l * DM; const float* bet = a.in[14] + l * DM;
#pragma unroll 1
          for (int m = d.gw; m < M; m += d.NGW) ln_row((const float*)(ws + WS_VBUF) + (size_t)m * DM, gam, bet, a.out + (size_t)m * DM, l + 1 < DEPTH ? (bf16*)(ws + WS_XB) + (size_t)m * DM : nullptr, d.lane); }
        }
        if (ph + 1 < 1 + 5 * DEPTH) xcd_barrier(bar);
    }
}

extern "C" void kernel_launch(void* const* d_in, const int* in_sizes, int n_in, void* d_out, int out_size, void* d_ws, size_t ws_size, hipStream_t stream) {
    static int grid = 0;
    if (grid == 0) {
        if (n_in != 15 || in_sizes[0] != M * DM || out_size != M * DM || ws_size < WS_END) { fprintf(stderr, "kernel_launch: unexpected shapes / workspace (n_in %d, in0 %d, out %d, ws %zu); nothing launched\n", n_in, n_in > 0 ? in_sizes[0] : -1, out_size, ws_size); grid = -1; return; }
        int dev = 0, cus = 0;
        if (hipGetDevice(&dev) != hipSuccess || hipDeviceGetAttribute(&cus, hipDeviceAttributeMultiprocessorCount, dev) != hipSuccess) { fprintf(stderr, "kernel_launch: device query failed\n"); grid = -1; return; }
        if (hipFuncSetAttribute((const void*)fwd_kernel, hipFuncAttributeMaxDynamicSharedMemorySize, LDS_BYTES) != hipSuccess) { fprintf(stderr, "kernel_launch: hipFuncSetAttribute failed\n"); grid = -1; return; }
        int per_cu = 0;
        if (hipOccupancyMaxActiveBlocksPerMultiprocessor(&per_cu, (const void*)fwd_kernel, NWAVES * 64, LDS_BYTES) != hipSuccess || per_cu < 1) fprintf(stderr, "kernel_launch: note: occupancy query reports %d workgroups per CU\n", per_cu);
        (void)hipGetLastError();
        grid = cus;
    }
    if (grid < 0) return;
    if (hipMemsetAsync((char*)d_ws + WS_CTL, 0, CTL_ZERO_BYTES, stream) != hipSuccess) { fprintf(stderr, "kernel_launch: hipMemsetAsync failed\n"); return; }
    KArgs a{};
    for (int i = 0; i < 15; ++i) a.in[i] = (const float*)d_in[i];
    a.out = (float*)d_out; a.ws = (unsigned char*)d_ws;
    hipLaunchKernelGGL(fwd_kernel, dim3(grid), dim3(NWAVES * 64), LDS_BYTES, stream, a);
    const hipError_t le = hipPeekAtLastError();
    if (le != hipSuccess) fprintf(stderr, "kernel_launch: launch failed: %s\n", hipGetErrorName(le));
}
```
